# Optimizing an MI355X kernel written in HIP

```python
import math
import jax
import jax.numpy as jnp
from jax import lax
import numpy as np

D_MODEL = 1024
BATCH = 2
SEQ = 16384
DEPTH = 4

GRID_W = 64
CTX_LEN = 256
D_MIX = D_MODEL
HEAD_DIM = 64
D_HY = D_MIX // 4
D_LRU = D_MIX // 4
N_HEADS_WIN = (D_MIX // 4) // HEAD_DIM
N_KV_WIN = N_HEADS_WIN // 2
N_HEADS_GLB = (D_MIX // 4) // HEAD_DIM
N_KV_GLB = N_HEADS_GLB // 2
D_FF = 2816
N_MOD = 9
WINDOW = 128
Q_BLOCK = 128
HY_ORDER = 2
HY_SHORT = 3
HY_PAD = (1, 1)
LRU_SHORT = 4
LRU_PAD = (2, 1)
HY_BANDS = 16
HY_EMB = 1 + 2 * HY_BANDS
HY_HIDDEN = 64
HY_MIN_DECAY = math.log(1e-2) / 1.5
HY_MAX_DECAY = math.log(1e-2) / 0.3
LRU_BLOCKS = 4
LRU_BLOCK_DIM = D_LRU // LRU_BLOCKS
LRU_C = 8.0
ROPE_BASE = 10000.0
ROPE_FREQS = HEAD_DIM // 4
EPS = 1e-6
NEG_INF = -1e30
SPLIT_SIZES = (3 * D_HY, D_LRU, D_LRU,
               N_HEADS_WIN * HEAD_DIM, N_KV_WIN * HEAD_DIM, N_KV_WIN * HEAD_DIM,
               N_HEADS_GLB * HEAD_DIM, N_KV_GLB * HEAD_DIM, N_KV_GLB * HEAD_DIM)
SPLIT_IDX = tuple(int(i) for i in np.cumsum(SPLIT_SIZES)[:-1])
D_IN = sum(SPLIT_SIZES)
F32 = jnp.float32

kernel_name = 'hybrid_headgroup_diffusion_trunk'


def rmsnorm(x, g):
    x32 = x.astype(F32)
    y = x32 * lax.rsqrt(jnp.mean(x32 * x32, axis=-1, keepdims=True) + EPS)
    return (y * g.astype(F32)).astype(x.dtype)


def adaln_in(h, g, shift, scale):
    return rmsnorm(h, g) * (1 + scale) + shift


def swiglu(h, w13, w2):
    gate, up = jnp.split(h @ w13, 2, axis=-1)
    return (jax.nn.silu(gate) * up) @ w2


def depthwise_conv(u, w, b, pad):
    y = lax.conv_general_dilated(u, w[:, None, :].astype(u.dtype), window_strides=(1,), padding=[pad],
                                 dimension_numbers=('NWC', 'WIO', 'NWC'), feature_group_count=u.shape[-1])
    return y + b


def heads(z):
    return z.reshape(*z.shape[:-1], -1, HEAD_DIM)


def axial_rope(n_tokens):
    rows = n_tokens // GRID_W
    row = jnp.repeat(jnp.arange(rows, dtype=F32), GRID_W, total_repeat_length=n_tokens)
    col = jnp.tile(jnp.arange(GRID_W, dtype=F32), rows)
    inv = ROPE_BASE ** (-jnp.arange(ROPE_FREQS, dtype=F32) / ROPE_FREQS)
    ang = jnp.concatenate([row[:, None] * inv, col[:, None] * inv], axis=-1)
    return jnp.cos(ang), jnp.sin(ang)


def apply_rope(z, cos, sin):
    z32 = z.astype(F32)
    z1, z2 = jnp.split(z32, 2, axis=-1)
    c, s = cos[:, None, :], sin[:, None, :]
    return jnp.concatenate([z1 * c - z2 * s, z1 * s + z2 * c], axis=-1).astype(z.dtype)


def hyena_filter_spectrum(n, w1, b1, freq, w2, b2, w3):
    t = jnp.linspace(0.0, 1.0, n, dtype=F32)[:, None]
    w = 2.0 * math.pi * jnp.arange(n, dtype=F32)[:, None] / n
    f = jnp.linspace(1e-4, HY_BANDS - 1, HY_BANDS, dtype=F32)[None, :]
    z = jnp.concatenate([t, jnp.cos(f * w), -jnp.sin(f * w)], axis=-1)
    h = jnp.sin(freq[0] * (z @ w1 + b1))
    h = jnp.sin(freq[1] * (h @ w2 + b2))
    h = (h @ w3).astype(F32).reshape(n, HY_ORDER, 2, D_HY)
    deltas = jnp.abs(jnp.linspace(HY_MIN_DECAY, HY_MAX_DECAY, D_HY, dtype=F32))
    h = h * jnp.exp(-t[:, :, None, None] * deltas)
    h = h / (jnp.sum(jnp.abs(h), axis=(0, 2), keepdims=True) + EPS)
    fwd, bwd = h[:, :, 0], h[:, :, 1]
    k = jnp.concatenate([fwd, jnp.zeros_like(fwd[:1]), bwd[:0:-1]], axis=0)
    return jnp.fft.rfft(k, axis=0)


def hyena_mixer(u, kf, skip):
    n = u.shape[1]
    v, x1, x2 = jnp.split(u, 3, axis=-1)

    def long_conv(z, k_f, s):
        z32 = z.astype(F32)
        zf = jnp.fft.rfft(z32, n=2 * n, axis=1)
        y = jnp.fft.irfft(zf * k_f[None], n=2 * n, axis=1)[:, :n]
        return (y + z32 * s.astype(F32)).astype(z.dtype)

    z = x1 * long_conv(v, kf[:, 0], skip[0])
    return x2 * long_conv(z, kf[:, 1], skip[1])


def block_diag(z, w, b):
    zb = z.reshape(*z.shape[:-1], LRU_BLOCKS, LRU_BLOCK_DIM)
    return jnp.einsum('blnd,nde->blne', zb, w).reshape(z.shape) + b


def rglru_coeffs(u, wa, ba, wx, bx, lam):
    r = jax.nn.sigmoid(block_diag(u, wa, ba).astype(F32))
    i = jax.nn.sigmoid(block_diag(u, wx, bx).astype(F32))
    log_a = -LRU_C * r * jax.nn.softplus(-lam.astype(F32))
    return jnp.exp(log_a), jnp.sqrt(-jnp.expm1(2.0 * log_a)) * i * u.astype(F32)


def linear_scan(a, b, h0=None):
    if h0 is not None:
        b = b.at[:, 0].add(a[:, 0] * h0)

    def combine(lft, rgt):
        return (lft[0] * rgt[0], rgt[0] * lft[1] + rgt[1])

    return lax.associative_scan(combine, (a, b), axis=1)[1]


def flip_seq(z, d):
    return z[:, ::-1] if d == 1 else z


def rglru_bidirectional(ul, uc, wa, ba, wx, bx, lam):
    yl, yc = 0.0, 0.0
    for d in range(2):
        a_c, b_c = rglru_coeffs(flip_seq(uc, d), wa[d], ba[d], wx[d], bx[d], lam[d])
        h_c = linear_scan(a_c, b_c)
        a_l, b_l = rglru_coeffs(flip_seq(ul, d), wa[d], ba[d], wx[d], bx[d], lam[d])
        h_l = linear_scan(a_l, b_l, h_c[:, -1])
        yl = yl + flip_seq(h_l, d)
        yc = yc + flip_seq(h_c, d)
    return yl, yc


def dense_attention(q, k, v, sink):
    B, n, H, dh = q.shape
    KVH, m = k.shape[2], k.shape[1]
    G = H // KVH
    s = jnp.einsum('bqkgd,bskd->bkgqs', q.reshape(B, n, KVH, G, dh), k, preferred_element_type=F32) * dh ** -0.5
    if sink is not None:
        s = jnp.concatenate([s, jnp.broadcast_to(sink.astype(F32).reshape(1, KVH, G, 1, 1), s.shape[:-1] + (1,))], axis=-1)
    p = jax.nn.softmax(s, axis=-1)[..., :m].astype(v.dtype)
    return jnp.einsum('bkgqs,bskd->bqkgd', p, v).reshape(B, n, H * dh)


def window_attention(q, k, v, kc, vc, sink):
    B, n, H, dh = q.shape
    KVH = k.shape[2]
    G = H // KVH
    C = kc.shape[1]
    nb = n // Q_BLOCK
    qb = q.reshape(B, nb, Q_BLOCK, KVH, G, dh)

    def band(z):
        zp = jnp.pad(z, ((0, 0), (Q_BLOCK, Q_BLOCK), (0, 0), (0, 0))).reshape(B, nb + 2, Q_BLOCK, KVH, dh)
        return jnp.concatenate([zp[:, :-2], zp[:, 1:-1], zp[:, 2:]], axis=2)

    kb, vb = band(k), band(v)
    scale = dh ** -0.5
    s_loc = jnp.einsum('bnqkgd,bnskd->bnkgqs', qb, kb, preferred_element_type=F32) * scale
    s_ctx = jnp.einsum('bnqkgd,bskd->bnkgqs', qb, kc, preferred_element_type=F32) * scale
    qpos = jnp.arange(nb)[:, None] * Q_BLOCK + jnp.arange(Q_BLOCK)[None, :]
    kpos = (jnp.arange(nb)[:, None] - 1) * Q_BLOCK + jnp.arange(3 * Q_BLOCK)[None, :]
    kp = kpos[:, None, :]
    valid = (jnp.abs(kp - qpos[:, :, None]) <= WINDOW) & (kp >= 0) & (kp < n)
    s_loc = jnp.where(valid[None, :, None, None], s_loc, NEG_INF)
    s_sink = jnp.broadcast_to(sink.astype(F32).reshape(1, 1, KVH, G, 1, 1), s_loc.shape[:-1] + (1,))
    p = jax.nn.softmax(jnp.concatenate([s_loc, s_ctx, s_sink], axis=-1), axis=-1).astype(v.dtype)
    n_loc = 3 * Q_BLOCK
    o = (jnp.einsum('bnkgqs,bnskd->bnqkgd', p[..., :n_loc], vb)
         + jnp.einsum('bnkgqs,bskd->bnqkgd', p[..., n_loc:n_loc + C], vc))
    return o.reshape(B, n, H * dh)


def global_attention(q, k, v, kc, vc):
    B, n, H, dh = q.shape
    nb = n // Q_BLOCK
    k_all = jnp.concatenate([k, kc], axis=1)
    v_all = jnp.concatenate([v, vc], axis=1)
    qb = q.reshape(B, nb, Q_BLOCK, H, dh).transpose(1, 0, 2, 3, 4)
    o = lax.map(lambda qblk: dense_attention(qblk, k_all, v_all, None), qb)
    return o.transpose(1, 0, 2, 3).reshape(B, n, H * dh)


def setup_inputs(seed: int = 0) -> dict:
    key = jax.random.key(seed)
    ks = jax.random.split(key, 32)

    def nrm(k, shape, scale):
        return jax.random.normal(k, shape, F32) * scale

    D = D_MODEL
    a_c = jax.random.uniform(ks[27], (DEPTH, 2, D_LRU), F32, 0.9, 0.999) ** (1.0 / LRU_C)
    return {
        'x': nrm(ks[0], (BATCH, SEQ, D), 1.0),
        'c': nrm(ks[1], (BATCH, D), 1.0),
        'ctx': nrm(ks[2], (BATCH, CTX_LEN, D), 1.0),
        'c_ctx': nrm(ks[3], (D,), 1.0),
        'w_mod': nrm(ks[4], (DEPTH, D, N_MOD * D), 0.5 * D ** -0.5),
        'b_mod': nrm(ks[5], (DEPTH, N_MOD * D), 0.02),
        'norm_g': 1.0 + nrm(ks[6], (DEPTH, 3, D), 0.02),
        'ffn1_w13': nrm(ks[7], (DEPTH, D, 2 * D_FF), D ** -0.5),
        'ffn1_w2': nrm(ks[8], (DEPTH, D_FF, D), D_FF ** -0.5),
        'ffn2_w13': nrm(ks[9], (DEPTH, D, 2 * D_FF), D ** -0.5),
        'ffn2_w2': nrm(ks[10], (DEPTH, D_FF, D), D_FF ** -0.5),
        'w_in': nrm(ks[11], (DEPTH, D, D_IN), D ** -0.5),
        'w_out': nrm(ks[12], (DEPTH, D_MIX, D), D_MIX ** -0.5),
        'hy_conv_w': nrm(ks[13], (DEPTH, HY_SHORT, 3 * D_HY), HY_SHORT ** -0.5),
        'hy_conv_b': nrm(ks[14], (DEPTH, 3 * D_HY), 0.02),
        'hy_w1': nrm(ks[15], (DEPTH, HY_EMB, HY_HIDDEN), HY_EMB ** -0.5),
        'hy_b1': nrm(ks[16], (DEPTH, HY_HIDDEN), 0.02),
        'hy_freq': 1.0 + nrm(ks[17], (DEPTH, 2, HY_HIDDEN), 0.1),
        'hy_w2': nrm(ks[18], (DEPTH, HY_HIDDEN, HY_HIDDEN), HY_HIDDEN ** -0.5),
        'hy_b2': nrm(ks[19], (DEPTH, HY_HIDDEN), 0.02),
        'hy_w3': nrm(ks[20], (DEPTH, HY_HIDDEN, HY_ORDER * 2 * D_HY), HY_HIDDEN ** -0.5),
        'hy_skip': nrm(ks[21], (DEPTH, HY_ORDER, D_HY), 0.5),
        'lru_conv_w': nrm(ks[22], (DEPTH, LRU_SHORT, D_LRU), LRU_SHORT ** -0.5),
        'lru_conv_b': nrm(ks[23], (DEPTH, D_LRU), 0.02),
        'lru_wa': nrm(ks[24], (DEPTH, 2, LRU_BLOCKS, LRU_BLOCK_DIM, LRU_BLOCK_DIM), LRU_BLOCK_DIM ** -0.5),
        'lru_ba': nrm(ks[25], (DEPTH, 2, D_LRU), 0.02),
        'lru_wx': nrm(ks[26], (DEPTH, 2, LRU_BLOCKS, LRU_BLOCK_DIM, LRU_BLOCK_DIM), LRU_BLOCK_DIM ** -0.5),
        'lru_bx': nrm(ks[28], (DEPTH, 2, D_LRU), 0.02),
        'lru_lambda': jnp.log(a_c) - jnp.log1p(-a_c),
        'win_sink': nrm(ks[29], (DEPTH, N_HEADS_WIN), 1.0),
        'qk_gain': 1.0 + nrm(ks[30], (DEPTH, 2, HEAD_DIM), 0.02),
        'final_g': 1.0 + nrm(ks[31], (D,), 0.02),
    }


def reference(x, c, ctx, c_ctx, w_mod, b_mod, norm_g, ffn1_w13, ffn1_w2, ffn2_w13, ffn2_w2, w_in, w_out,
              hy_conv_w, hy_conv_b, hy_w1, hy_b1, hy_freq, hy_w2, hy_b2, hy_w3, hy_skip,
              lru_conv_w, lru_conv_b, lru_wa, lru_ba, lru_wx, lru_bx, lru_lambda,
              win_sink, qk_gain, final_g):
    n = x.shape[1]
    n_ctx = ctx.shape[1]
    cos, sin = axial_rope(n)
    for l in range(DEPTH):
        last = l == DEPTH - 1
        ml = jnp.split((jax.nn.silu(c) @ w_mod[l] + b_mod[l])[:, None, :], N_MOD, axis=-1)
        mc = jnp.split((jax.nn.silu(c_ctx) @ w_mod[l] + b_mod[l])[None, None, :], N_MOD, axis=-1)

        x = x + 0.5 * ml[2] * swiglu(adaln_in(x, norm_g[l, 0], ml[0], ml[1]), ffn1_w13[l], ffn1_w2[l])
        ctx = ctx + 0.5 * mc[2] * swiglu(adaln_in(ctx, norm_g[l, 0], mc[0], mc[1]), ffn1_w13[l], ffn1_w2[l])

        hl = adaln_in(x, norm_g[l, 1], ml[3], ml[4])
        hc = adaln_in(ctx, norm_g[l, 1], mc[3], mc[4])
        pl = jnp.split(hl @ w_in[l], SPLIT_IDX, axis=-1)
        pc = jnp.split(hc @ w_in[l], SPLIT_IDX, axis=-1)

        kf_l = hyena_filter_spectrum(n, hy_w1[l], hy_b1[l], hy_freq[l], hy_w2[l], hy_b2[l], hy_w3[l])
        y_hy = hyena_mixer(depthwise_conv(pl[0], hy_conv_w[l], hy_conv_b[l], HY_PAD), kf_l, hy_skip[l])

        r_l = depthwise_conv(pl[1], lru_conv_w[l], lru_conv_b[l], LRU_PAD)
        r_c = depthwise_conv(pc[1], lru_conv_w[l], lru_conv_b[l], LRU_PAD)
        h_l, h_c = rglru_bidirectional(r_l, r_c, lru_wa[l], lru_ba[l], lru_wx[l], lru_bx[l], lru_lambda[l])
        y_lru = jax.nn.gelu(pl[2]) * h_l.astype(x.dtype)

        kwc, vwc = heads(pc[4]), heads(pc[5])
        y_win = window_attention(apply_rope(heads(pl[3]), cos, sin), apply_rope(heads(pl[4]), cos, sin),
                                 heads(pl[5]), kwc, vwc, win_sink[l])

        kgc, vgc = rmsnorm(heads(pc[7]), qk_gain[l, 1]), heads(pc[8])
        y_glb = global_attention(apply_rope(rmsnorm(heads(pl[6]), qk_gain[l, 0]), cos, sin),
                                 apply_rope(rmsnorm(heads(pl[7]), qk_gain[l, 1]), cos, sin),
                                 heads(pl[8]), kgc, vgc)

        x = x + ml[5] * (jnp.concatenate([y_hy, y_lru, y_win, y_glb], axis=-1) @ w_out[l])

        if not last:
            kf_c = hyena_filter_spectrum(n_ctx, hy_w1[l], hy_b1[l], hy_freq[l], hy_w2[l], hy_b2[l], hy_w3[l])
            yc_hy = hyena_mixer(depthwise_conv(pc[0], hy_conv_w[l], hy_conv_b[l], HY_PAD), kf_c, hy_skip[l])
            yc_lru = jax.nn.gelu(pc[2]) * h_c.astype(ctx.dtype)
            yc_win = dense_attention(heads(pc[3]), kwc, vwc, win_sink[l])
            yc_glb = dense_attention(rmsnorm(heads(pc[6]), qk_gain[l, 0]), kgc, vgc, None)
            ctx = ctx + mc[5] * (jnp.concatenate([yc_hy, yc_lru, yc_win, yc_glb], axis=-1) @ w_out[l])

        x = x + 0.5 * ml[8] * swiglu(adaln_in(x, norm_g[l, 2], ml[6], ml[7]), ffn2_w13[l], ffn2_w2[l])
        if not last:
            ctx = ctx + 0.5 * mc[8] * swiglu(adaln_in(ctx, norm_g[l, 2], mc[6], mc[7]), ffn2_w13[l], ffn2_w2[l])

    return rmsnorm(x, final_g)
```

```cpp
#include <hip/hip_runtime.h>
#include <hip/hip_cooperative_groups.h>
#include <hip/hip_bf16.h>
#include <cstdio>
#include <cstdint>
#include <cmath>
namespace cg = cooperative_groups;
namespace pg8 {
#define PG8_LAS __attribute__((address_space(3)))
typedef unsigned short bf16_t;
typedef short bf16x8 __attribute__((ext_vector_type(8)));
typedef float f32x4 __attribute__((ext_vector_type(4)));
typedef unsigned u32x4 __attribute__((ext_vector_type(4)));
constexpr int BM = 256, BK = 64, HALF = 128, HTB = HALF * BK * 2  , STAGE_BYTES = 8 * HTB, NXCD = 8, WGM = 8;

__host__ __device__ __forceinline__ int lds_byte(int r, int c) { const int st = (r >> 4) * 2 + (c >> 5), rr = r & 15, cc = c & 31, ob = rr * 64 + cc * 2; return st * 1024 + (ob ^ (((ob >> 9) & 1) << 5)); }
__host__ __device__ __forceinline__ void stage_rc(int b, int& R, int& C) { const int st = b / 1024, sb = b % 1024, swz = sb ^ (((sb >> 9) & 1) << 5); R = (st >> 1) * 16 + swz / 64; C = (st & 1) * 32 + (swz % 64) / 2; }
__host__ __device__ __forceinline__ int perm32(int rho) { const int n = rho >> 4, i = rho & 15; return 8 * (i >> 2) + 4 * n + (i & 3); }

struct Unit { int pm, pn; };
struct Gemm { const bf16_t* A; const bf16_t* Bt; int M, N, K; int KL, nNr; };

struct StaticOrder {
    int nM, nN, nwg, G, c;
    __host__ __device__ void init(int M, int N, int G_, int c_) { nM = M / BM; nN = N / BM; nwg = nM * nN; G = G_; c = c_; }
    __host__ __device__ bool next(int i, Unit& u) const {
        const long L = (long)i * G + c; if (L >= nwg) return false;
        int wgid = (int)L; { const int q = nwg / NXCD, r = nwg % NXCD, xcd = wgid % NXCD, off = wgid / NXCD; wgid = (xcd < r ? xcd * (q + 1) : r * (q + 1) + (xcd - r) * q) + off; }
        const int nig = WGM * nN, gid = wgid / nig, fm = gid * WGM, gsz = (nM - fm) < WGM ? (nM - fm) : WGM;
        u.pm = fm + ((wgid % nig) % gsz); u.pn = (wgid % nig) / gsz; return true;
    }
    __device__ __forceinline__ void a_ready(const Unit&) const {}
    __device__ __forceinline__ void done(const Unit&) const {}
};

__device__ __forceinline__ unsigned cvt_pk_bf16(float lo, float hi) { unsigned r; asm volatile("v_cvt_pk_bf16_f32 %0, %1, %2" : "=v"(r) : "v"(lo), "v"(hi)); return r; }
typedef float f32x2 __attribute__((ext_vector_type(2)));
template <class Epi, class Sched, bool ALIGN_EPI = false, bool SP2 = false>
__device__ __forceinline__ void gemm_phase(PG8_LAS unsigned char* lds, const Gemm g, const Sched& S, const Epi& E) {
    int tid_ = threadIdx.x; asm volatile("" : "+v"(tid_));
    const int tid = tid_, wid = __builtin_amdgcn_readfirstlane(tid >> 6), lane = tid & 63, wr = wid >> 2, wc = wid & 3, fr = lane & 15, fq = lane >> 4;
    const int K = g.K, nt = g.KL / BK;
    unsigned voffA[2], voffB[2];
#pragma unroll
    for (int i = 0; i < 2; ++i) { int R, C; stage_rc(tid * 16 + i * 8192, R, C); const int Rb = Epi::PERM ? ((R & ~31) + perm32(R & 31)) : R;
        voffA[i] = (unsigned)(R * K + C) * 2u; voffB[i] = (unsigned)(Rb * K + C) * 2u; }
    const size_t kstep = (size_t)(BK * 2);
    const size_t hstep = (size_t)HALF * K * 2;
    const size_t tstep = 2 * hstep;
    const unsigned ldsw = (unsigned)wid * 1024u;
    const int aoff = lds_byte(wr * 64 + fr, fq * 8), boff = lds_byte(wc * 32 + fr, fq * 8);
#define PG8_SA(b, h) (((b) * 2 + (h)) * HTB)
#define PG8_SB(b, h) ((4 + (b) * 2 + (h)) * HTB)
#define PG8_STAGE(bufoff, gbase, voff) do { _Pragma("unroll") for (int _i = 0; _i < 2; ++_i) \
        __builtin_amdgcn_global_load_lds((const unsigned*)((const char*)(gbase) + (voff)[_i]), (PG8_LAS unsigned*)(lds + (bufoff) + ldsw + _i * 8192), 16, 0, 0); } while (0)
#define PG8_LDA(dst, b, h) do { _Pragma("unroll") for (int m = 0; m < 4; ++m) _Pragma("unroll") for (int k = 0; k < 2; ++k) dst[m][k] = *(const PG8_LAS bf16x8*)(lds + PG8_SA(b, h) + aoff + m * 2048 + k * 1024); } while (0)
#define PG8_LDB(dst, b, h) do { _Pragma("unroll") for (int n = 0; n < 2; ++n) _Pragma("unroll") for (int k = 0; k < 2; ++k) dst[n][k] = *(const PG8_LAS bf16x8*)(lds + PG8_SB(b, h) + boff + n * 2048 + k * 1024); } while (0)
#define PG8_MMA(ai, bj, At, Bt) do { __builtin_amdgcn_s_setprio(1); _Pragma("unroll") for (int m = 0; m < 4; ++m) _Pragma("unroll") for (int n = 0; n < 2; ++n) _Pragma("unroll") for (int k = 0; k < 2; ++k) \
        acc[ai][bj][m][n] = __builtin_amdgcn_mfma_f32_16x16x32_bf16(Bt[n][k], At[m][k], acc[ai][bj][m][n], 0, 0, 0); __builtin_amdgcn_s_setprio(0); } while (0)
#define PG8_WAIT_V(n) asm volatile("s_waitcnt vmcnt(" #n ")" ::: "memory")
#define PG8_WAIT_L(n) asm volatile("s_waitcnt lgkmcnt(" #n ")" ::: "memory")
#define PG8_BAR __builtin_amdgcn_s_barrier()
#define PG8_SCHED __builtin_amdgcn_sched_barrier(0)
    Unit cur, nxt; int ui = 0;
    if (!S.next(0, cur)) return;
    f32x4 acc[2][2][4][2];
#pragma unroll
    for (int a = 0; a < 2; ++a)
#pragma unroll
        for (int b = 0; b < 2; ++b)
#pragma unroll
            for (int m = 0; m < 4; ++m)
#pragma unroll
                for (int n = 0; n < 2; ++n) acc[a][b][m][n] = (f32x4){0.f, 0.f, 0.f, 0.f};
    bf16x8 At[4][2], B0[2][2], B1[2][2];
#define PG8_PA(u) ((const char*)g.A + (size_t)(u).pm * tstep + (size_t)((u).pn / g.nNr) * (size_t)g.KL * 2)
#define PG8_PB(u) ((const char*)g.Bt + (size_t)((u).pn % g.nNr) * tstep + (size_t)((u).pn / g.nNr) * (size_t)g.KL * 2)
    const char* cA = PG8_PA(cur); const char* cB = PG8_PB(cur);
    S.a_ready(cur);
    if constexpr (SP2) {
        PG8_STAGE(PG8_SB(0, 0), cB, voffB); PG8_STAGE(PG8_SB(0, 1), cB + hstep, voffB); PG8_STAGE(PG8_SA(0, 0), cA, voffA); PG8_STAGE(PG8_SA(0, 1), cA + hstep, voffA);
        if (wr == 1) PG8_BAR;
        PG8_WAIT_V(2); PG8_BAR;
        PG8_STAGE(PG8_SB(1, 0), cB + kstep, voffB); PG8_STAGE(PG8_SA(1, 0), cA + kstep, voffA); PG8_STAGE(PG8_SB(1, 1), cB + hstep + kstep, voffB);
        PG8_WAIT_V(6); PG8_BAR;
    } else {
        PG8_STAGE(PG8_SB(0, 0), cB, voffB); PG8_STAGE(PG8_SA(0, 0), cA, voffA); PG8_STAGE(PG8_SB(0, 1), cB + hstep, voffB); PG8_STAGE(PG8_SA(0, 1), cA + hstep, voffA);
        if (wr == 1) PG8_BAR;
        PG8_WAIT_V(4); PG8_BAR;
        PG8_STAGE(PG8_SB(1, 0), cB + kstep, voffB); PG8_STAGE(PG8_SA(1, 0), cA + kstep, voffA); PG8_STAGE(PG8_SB(1, 1), cB + hstep + kstep, voffB);
        PG8_WAIT_V(6); PG8_BAR;
    }
    for (;;) {
        const bool has_next = S.next(ui + 1, nxt);
        const char* nA = has_next ? PG8_PA(nxt) : cA; const char* nB = has_next ? PG8_PB(nxt) : cB;
        for (int t = 0; t < nt; t += 2) {
            const bool last = (t == nt - 2);
            const char* a1 = cA + (size_t)(t + 1) * kstep;
            const char* a2 = last ? nA : cA + (size_t)(t + 2) * kstep; const char* b2 = last ? nB : cB + (size_t)(t + 2) * kstep;
            const char* a3 = a2 + kstep; const char* b3 = b2 + kstep;
            if (last && has_next) S.a_ready(nxt);
            if constexpr (SP2) {
            PG8_LDB(B0, 0, 0); PG8_LDB(B1, 0, 1); PG8_SCHED; PG8_LDA(At, 0, 0); PG8_STAGE(PG8_SA(1, 1), a1 + hstep, voffA);
            PG8_WAIT_V(8); PG8_WAIT_L(0); PG8_BAR; PG8_MMA(0, 0, At, B0); PG8_MMA(0, 1, At, B1); PG8_BAR; PG8_SCHED;
            PG8_LDA(At, 0, 1); PG8_STAGE(PG8_SB(0, 0), b2, voffB); PG8_STAGE(PG8_SB(0, 1), b2 + hstep, voffB); PG8_STAGE(PG8_SA(0, 0), a2, voffA);
            PG8_WAIT_V(8); PG8_WAIT_L(0); PG8_BAR; PG8_MMA(1, 0, At, B0); PG8_MMA(1, 1, At, B1); PG8_BAR; PG8_SCHED;
            PG8_LDB(B0, 1, 0); PG8_LDB(B1, 1, 1); PG8_SCHED; PG8_LDA(At, 1, 0); PG8_STAGE(PG8_SA(0, 1), a2 + hstep, voffA);
            PG8_WAIT_V(8); PG8_WAIT_L(0); PG8_BAR; PG8_MMA(0, 0, At, B0); PG8_MMA(0, 1, At, B1); PG8_BAR; PG8_SCHED;
            PG8_LDA(At, 1, 1); PG8_STAGE(PG8_SB(1, 0), b3, voffB); PG8_STAGE(PG8_SB(1, 1), b3 + hstep, voffB); PG8_STAGE(PG8_SA(1, 0), a3, voffA);
            PG8_WAIT_V(8); PG8_WAIT_L(0); PG8_BAR; PG8_MMA(1, 0, At, B0); PG8_MMA(1, 1, At, B1); PG8_BAR; PG8_SCHED;
            } else {
            PG8_LDB(B0, 0, 0); PG8_SCHED; PG8_LDA(At, 0, 0); PG8_STAGE(PG8_SA(1, 1), a1 + hstep, voffA);
            PG8_WAIT_L(8); PG8_BAR; PG8_WAIT_L(0); PG8_MMA(0, 0, At, B0); PG8_BAR; PG8_SCHED;
            PG8_LDB(B1, 0, 1); PG8_STAGE(PG8_SB(0, 0), b2, voffB);
            PG8_BAR; PG8_WAIT_L(0); PG8_MMA(0, 1, At, B1); PG8_BAR;
            PG8_LDA(At, 0, 1); PG8_STAGE(PG8_SA(0, 0), a2, voffA);
            PG8_BAR; PG8_WAIT_L(0); PG8_MMA(1, 0, At, B0); PG8_BAR; PG8_SCHED;
            PG8_STAGE(PG8_SB(0, 1), b2 + hstep, voffB);
            PG8_WAIT_V(6); PG8_BAR; PG8_MMA(1, 1, At, B1); PG8_BAR;
            PG8_LDB(B0, 1, 0); PG8_SCHED; PG8_LDA(At, 1, 0); PG8_STAGE(PG8_SA(0, 1), a2 + hstep, voffA);
            PG8_WAIT_L(8); PG8_BAR; PG8_WAIT_L(0); PG8_MMA(0, 0, At, B0); PG8_BAR; PG8_SCHED;
            PG8_LDB(B1, 1, 1); PG8_STAGE(PG8_SB(1, 0), b3, voffB);
            PG8_BAR; PG8_WAIT_L(0); PG8_MMA(0, 1, At, B1); PG8_BAR;
            PG8_LDA(At, 1, 1); PG8_STAGE(PG8_SA(1, 0), a3, voffA);
            PG8_BAR; PG8_WAIT_L(0); PG8_MMA(1, 0, At, B0); PG8_BAR; PG8_SCHED;
            PG8_STAGE(PG8_SB(1, 1), b3 + hstep, voffB);
            PG8_WAIT_V(6); PG8_BAR; PG8_MMA(1, 1, At, B1); PG8_BAR;
            }
        }
        if constexpr (ALIGN_EPI) { if (wr == 0) PG8_BAR; }
        if constexpr (!Epi::AFTER_DRAIN) { E(acc, cur, wr, wc, fr, fq); S.done(cur); }
        if (!has_next) break;
#pragma unroll
        for (int a = 0; a < 2; ++a)
#pragma unroll
            for (int b = 0; b < 2; ++b)
#pragma unroll
                for (int m = 0; m < 4; ++m)
#pragma unroll
                    for (int n = 0; n < 2; ++n) acc[a][b][m][n] = (f32x4){0.f, 0.f, 0.f, 0.f};
        cur = nxt; cA = nA; cB = nB; ++ui;
        if constexpr (ALIGN_EPI) { if (wr == 1) PG8_BAR; }
    }
    PG8_WAIT_V(0);
    if constexpr (!ALIGN_EPI) { if (wr == 0) PG8_BAR; }
    PG8_BAR;
    if constexpr (Epi::AFTER_DRAIN) { E.fused(acc, cur, wr, wc, fr, fq, lds, wid, lane); S.done(cur); }
#undef PG8_SA
#undef PG8_SB
#undef PG8_STAGE
#undef PG8_LDA
#undef PG8_LDB
#undef PG8_MMA
#undef PG8_WAIT_V
#undef PG8_WAIT_L
#undef PG8_BAR
#undef PG8_SCHED
}
}
namespace attn_body {
using bf16=__hip_bfloat16;
using bf16x8=__attribute__((ext_vector_type(8)))short;
using s16x4=__attribute__((ext_vector_type(4)))short;
using f32x16=__attribute__((ext_vector_type(16)))float;
using u32x4=__attribute__((ext_vector_type(4)))unsigned;
constexpr int D=64,QP=1280,OP=1024;
constexpr int NW=8,QBLK=32,QB=QBLK*NW,KVBLK=64;
__device__ __forceinline__ int crow(int r,int hi){return (r&3)+8*(r>>2)+4*hi;}
#define SBAR() __builtin_amdgcn_sched_barrier(0)
__device__ __forceinline__ void wmask(f32x16&p0,f32x16&p1,int kb,int qpos){
  const float NEG=-INFINITY;
  #pragma unroll
  for(int r=0;r<16;++r){int dv=kb+(r&3)+8*(r>>2)-qpos; if(dv>128||dv<-128)p0[r]=NEG; if(dv+32>128||dv+32<-128)p1[r]=NEG;}
}

constexpr int NSLOT=3, SLOTB=8192;
constexpr int LDS_K=0, LDS_V=NSLOT*SLOTB, LDS_WS=2*NSLOT*SLOTB, LDS_OST=LDS_WS+NW*64*4, LDS_BYTES=LDS_OST+NW*4096;
constexpr float C2=0.125f*1.4426950408889634f;
__device__ __forceinline__ void glds16(const void*gsrc,unsigned lds_dst){unsigned keep;
  asm volatile("s_mov_b32 %0, m0\n\ts_mov_b32 m0, %2\n\ts_nop 0\n\tglobal_load_lds_dwordx4 %1, off\n\ts_mov_b32 m0, %0":"=&s"(keep):"v"(gsrc),"s"(lds_dst):"memory");}
__device__ __forceinline__ float max3f(float a,float b,float c){float r;asm("v_max3_f32 %0, %1, %2, %3":"=v"(r):"v"(a),"v"(b),"v"(c));return r;}
__device__ __forceinline__ float max2f(float a,float b){float r;asm("v_max_f32_e32 %0, %1, %2":"=v"(r):"v"(a),"v"(b));return r;}
__device__ __forceinline__ float fadd_s(float a,float b){float r;asm("v_add_f32_e32 %0, %1, %2":"=v"(r):"v"(a),"v"(b));return r;}
__device__ __forceinline__ float fsub_s(float a,float b){float r;asm("v_sub_f32_e32 %0, %1, %2":"=v"(r):"v"(a),"v"(b));return r;}
typedef float f32x2_t __attribute__((ext_vector_type(2))); typedef __bf16 bf16x2_t __attribute__((ext_vector_type(2)));
__device__ __forceinline__ unsigned cvtpk_s(float lo,float hi){f32x2_t v={lo,hi};bf16x2_t b=__builtin_convertvector(v,bf16x2_t);return __builtin_bit_cast(unsigned,b);}
#define WAIT_BAR(N) asm volatile("s_waitcnt vmcnt(" #N ") lgkmcnt(0)\n\ts_barrier":::"memory")

__device__ __forceinline__ void qkt(f32x16&p0,f32x16&p1,const char*Kslot,const bf16x8*qr,const f32x16&negm,int r32,int hi){
  const char*kb=Kslot+hi*1024+r32*16;
  #pragma unroll
  for(int d0=0;d0<4;++d0){
    const bf16x8 b0=*reinterpret_cast<const bf16x8*>(kb+d0*2048);
    const bf16x8 b1=*reinterpret_cast<const bf16x8*>(kb+d0*2048+512);
    if(d0==0){p0=__builtin_amdgcn_mfma_f32_32x32x16_bf16(b0,qr[0],negm,0,0,0);p1=__builtin_amdgcn_mfma_f32_32x32x16_bf16(b1,qr[0],negm,0,0,0);}
    else{p0=__builtin_amdgcn_mfma_f32_32x32x16_bf16(b0,qr[d0],p0,0,0,0);p1=__builtin_amdgcn_mfma_f32_32x32x16_bf16(b1,qr[d0],p1,0,0,0);}}
}
typedef __attribute__((address_space(3))) const char* lds_cptr;
typedef short v4i16_t __attribute__((ext_vector_type(4)));
__device__ __forceinline__ void kload8(bf16x8*kf,lds_cptr kp){
  kf[0]=*(const __attribute__((address_space(3))) bf16x8*)(kp);      kf[1]=*(const __attribute__((address_space(3))) bf16x8*)(kp+512);
  kf[2]=*(const __attribute__((address_space(3))) bf16x8*)(kp+2048); kf[3]=*(const __attribute__((address_space(3))) bf16x8*)(kp+2560);
  kf[4]=*(const __attribute__((address_space(3))) bf16x8*)(kp+4096); kf[5]=*(const __attribute__((address_space(3))) bf16x8*)(kp+4608);
  kf[6]=*(const __attribute__((address_space(3))) bf16x8*)(kp+6144); kf[7]=*(const __attribute__((address_space(3))) bf16x8*)(kp+6656);
}
__device__ __forceinline__ void kload2(bf16x8*kf,lds_cptr kp,int j){ kf[2*j]=*(const __attribute__((address_space(3))) bf16x8*)(kp+j*2048); kf[2*j+1]=*(const __attribute__((address_space(3))) bf16x8*)(kp+j*2048+512); }
__device__ __forceinline__ s16x4 vtr(lds_cptr p){ return __builtin_bit_cast(s16x4,__builtin_amdgcn_ds_read_tr16_b64_v4i16((__attribute__((address_space(3))) v4i16_t*)p)); }
__device__ __forceinline__ float rowmax(const f32x16&p0,const f32x16&p1){
  float a=max3f(p0[0],p0[1],p1[0]),b=max3f(p0[2],p0[3],p1[1]);a=max3f(a,p1[2],p1[3]);
  #pragma unroll
  for(int r=4;r<16;r+=4){a=max3f(a,p0[r],p0[r+1]);b=max3f(b,p0[r+2],p0[r+3]);a=max3f(a,p1[r],p1[r+1]);b=max3f(b,p1[r+2],p1[r+3]);}
  const float m=max2f(a,b);
  auto rr=__builtin_amdgcn_permlane32_swap(__float_as_uint(m),__float_as_uint(m),false,false);
  return max2f(__uint_as_float(rr[0]),__uint_as_float(rr[1]));
}
__device__ __forceinline__ void pv(f32x16*o,int vb,bf16x8 pa0,bf16x8 pa1,bf16x8 pa2,bf16x8 pa3){
  #pragma unroll
  for(int d0=0;d0<2;++d0){s16x4 lo[4],hi[4];
    #pragma unroll
    for(int ks=0;ks<4;++ks){
      asm volatile("ds_read_b64_tr_b16 %0,%1 offset:%c2":"=&v"(lo[ks]):"v"(vb),"i"(d0*4096+ks*1024):"memory");
      asm volatile("ds_read_b64_tr_b16 %0,%1 offset:%c2":"=&v"(hi[ks]):"v"(vb),"i"(d0*4096+ks*1024+512):"memory");}
    asm volatile("s_waitcnt lgkmcnt(0)":::"memory");SBAR();
    #define PK(k) (bf16x8){lo[k][0],lo[k][1],lo[k][2],lo[k][3],hi[k][0],hi[k][1],hi[k][2],hi[k][3]}
    o[d0]=__builtin_amdgcn_mfma_f32_32x32x16_bf16(pa0,PK(0),o[d0],0,0,0);
    o[d0]=__builtin_amdgcn_mfma_f32_32x32x16_bf16(pa1,PK(1),o[d0],0,0,0);
    o[d0]=__builtin_amdgcn_mfma_f32_32x32x16_bf16(pa2,PK(2),o[d0],0,0,0);
    o[d0]=__builtin_amdgcn_mfma_f32_32x32x16_bf16(pa3,PK(3),o[d0],0,0,0);
    #undef PK
  }
}

#ifndef ATTN_STORE16
#define ATTN_STORE16(p,v) (*(u32x4*)(p)=(v))
#endif
struct AttnJob { const bf16*Q; const bf16*K; const bf16*V; bf16*O; int qrow0, ctxrow0, bandrow0, NT, qpos0, kpos0; float sink2; int has_sink; };
template<int THRL,bool MASK> __device__ __forceinline__ void attn_unit(const AttnJob J,char*shm){
  int tid_=threadIdx.x; asm volatile("":"+v"(tid_)); const int tid=tid_,lane=tid&63,r32=lane&31,hi=lane>>5; const int wid=__builtin_amdgcn_readfirstlane(tid>>6);
  const bf16*Qw=J.Q+(long)(J.qrow0+wid*QBLK)*QP;
  const bf16*Kh=J.K,*Vh=J.V;
  const unsigned lds0=(unsigned)(uintptr_t)shm;
  float*wsf=(float*)(shm+LDS_WS)+wid*64;
  const bf16*ksrc=Kh+(long)lane*QP+wid*8;
  const bf16*vsrc=Vh+(long)(16*(wid&3)+(lane>>2))*QP+(wid>>2)*32+(lane&3)*8;
  const unsigned kdst=lds0+LDS_K+wid*1024, vdst=lds0+LDS_V+wid*1024;
  #define TROW(t) ((long)(((t)<4)?(J.ctxrow0+64*(t)):(J.bandrow0+64*((t)-4))))
  #define DMA_K(t,slot) glds16(ksrc+TROW(t)*QP,(unsigned)__builtin_amdgcn_readfirstlane(kdst+(slot)))
  #define DMA_V(t,slot) glds16(vsrc+TROW(t)*QP,(unsigned)__builtin_amdgcn_readfirstlane(vdst+(slot)))
  const int vb0=(int)(lds0+LDS_V)+((lane>>4)&1)*32+(lane&3)*8+(4*hi+((lane&15)>>2))*64;
  const char*Kbase=shm+LDS_K; bf16x8 kf[8];
  const lds_cptr shm3=(lds_cptr)shm; const lds_cptr kp0=shm3+LDS_K+hi*1024+r32*16; const lds_cptr vp0=shm3+LDS_V+((lane>>4)&1)*32+(lane&3)*8+(4*hi+((lane&15)>>2))*64;
  const int NT=J.NT;
  DMA_K(0,0);DMA_V(0,0);DMA_K(1,SLOTB);
  bf16x8 qr[4];
  #pragma unroll
  for(int d0=0;d0<4;++d0)qr[d0]=*reinterpret_cast<const bf16x8*>(&Qw[(long)r32*QP+d0*16+hi*8]);
  float mhat=0.f,l_reg=0.f;f32x16 o[2];o[0]=f32x16{};o[1]=f32x16{};f32x16 negm=f32x16{};asm volatile("":"+v"(negm));
  const int qpos=J.qpos0+wid*QBLK+r32;
  #define CMASK(P0,P1,t) do{ if constexpr(MASK){ if((t)>=4) wmask(P0,P1,J.kpos0+64*((t)-4)+4*hi,qpos); } }while(0)
  bool resc=false;
  #define START(P0,P1) do{ const float rm=rowmax(P0,P1); resc=false; \
    { const float dl=rm; mhat=fadd_s(mhat,dl); \
      _Pragma("unroll") for(int r=0;r<16;++r){P0[r]=fsub_s(P0[r],dl);P1[r]=fsub_s(P1[r],dl);} \
      _Pragma("unroll") for(int r=0;r<16;++r)negm[r]=-mhat; asm volatile("":"+v"(negm)); } \
    _Pragma("unroll") for(int r=0;r<16;++r)P0[r]=__builtin_amdgcn_exp2f(P0[r]); }while(0)
  #define RESC() do{ if(resc){ asm volatile("s_waitcnt lgkmcnt(0)":::"memory"); \
      _Pragma("unroll") for(int d_=0;d_<2;++d_) _Pragma("unroll") for(int r=0;r<16;++r)o[d_][r]*=wsf[crow(r,hi)]; } }while(0)
  f32x16 pA0,pA1,pB0,pB1;
  int sl_prev=0,sl_cur=0,sl_next=SLOTB;
  #define ROT() do{sl_prev=sl_cur;sl_cur=sl_next;sl_next=(sl_next==(NSLOT-1)*SLOTB)?0:sl_next+SLOTB;}while(0)
  DMA_K(2,2*SLOTB);
  WAIT_BAR(3);
  qkt(pA0,pA1,Kbase,qr,negm,r32,hi);asm volatile("s_nop 15\n\ts_nop 7":"+v"(pA0),"+v"(pA1));CMASK(pA0,pA1,0);
  START(pA0,pA1);
  _Pragma("unroll") for(int r=0;r<16;++r)pA1[r]=__builtin_amdgcn_exp2f(pA1[r]);
  WAIT_BAR(0);
  DMA_K(3,0);DMA_V(1,SLOTB);
  ROT();
  kload8(kf,kp0+sl_cur);
  WAIT_BAR(2);
  s16x4 vlo[8],vhi[8]; u32x4 pw0,pw1,pw2,pw3;
  #define PKW(P,B) cvtpk_s(P[B],P[B+1])
  #define PAF(k) __builtin_bit_cast(bf16x8,pw##k)
  #define VFR(i) (bf16x8){vlo[i][0],vlo[i][1],vlo[i][2],vlo[i][3],vhi[i][0],vhi[i][1],vhi[i][2],vhi[i][3]}
  #define PIN(x) asm volatile("":"+v"(x))
  #define MX3(a,b,c) __builtin_fmaxf(__builtin_fmaxf((a),(b)),(c))
  #define GAPA(MF,A0,A1,A2,A3,W0,W1,PW) do{ MF; sacc+=A0; sacc+=A1; sacc+=A2; sacc+=A3; PIN(sacc); W0; W1; PIN(PW); SBAR(); }while(0)
  #define EX(v) __builtin_amdgcn_exp2f(v)
  #define GAPB(MF,X,B) do{ MF; X[B]=EX(X[B]); X[B+1]=EX(X[B+1]); X[B+2]=EX(X[B+2]); X[B+3]=EX(X[B+3]); PIN(X); SBAR(); }while(0)
  #define VRD(i) do{ vlo[i]=vtr(vp_+(((i)>>2)*4096+((i)&3)*1024)); vhi[i]=vtr(vp_+(((i)>>2)*4096+((i)&3)*1024+512)); }while(0)
  #define KRD(G,j) do{ if(G){ kload2(kf,kp0+sl_next,j); SBAR(); } }while(0)
  #define STEP(C0,C1,P0,P1,t,GK,GV,GL) do{ SBAR(); \
    const lds_cptr vp_=vp0+sl_prev; \
    VRD(0); SBAR(); float sacc=(P0[0]+P0[1]); \
    GAPA(C0=__builtin_amdgcn_mfma_f32_32x32x16_bf16(kf[0],qr[0],negm,0,0,0), P0[2],P0[3],P0[4],P0[5],     pw0[0]=PKW(P0,0), pw0[1]=PKW(P0,2), pw0); \
    VRD(4); SBAR(); GAPA(C1=__builtin_amdgcn_mfma_f32_32x32x16_bf16(kf[1],qr[0],negm,0,0,0), P0[6],P0[7],P0[8],P0[9],     pw0[2]=PKW(P0,4), pw0[3]=PKW(P0,6), pw0); \
    VRD(1); SBAR(); GAPA(C0=__builtin_amdgcn_mfma_f32_32x32x16_bf16(kf[2],qr[1],C0,0,0,0),   P0[10],P0[11],P0[12],P0[13], pw1[0]=PKW(P0,8), pw1[1]=PKW(P0,10), pw1); \
    VRD(5); SBAR(); GAPA(C1=__builtin_amdgcn_mfma_f32_32x32x16_bf16(kf[3],qr[1],C1,0,0,0),   P0[14],P0[15],P1[0],P1[1],   pw1[2]=PKW(P0,12),pw1[3]=PKW(P0,14), pw1); \
    VRD(2); SBAR(); GAPA(C0=__builtin_amdgcn_mfma_f32_32x32x16_bf16(kf[4],qr[2],C0,0,0,0),   P1[2],P1[3],P1[4],P1[5],     pw2[0]=PKW(P1,0), pw2[1]=PKW(P1,2), pw2); \
    VRD(6); SBAR(); GAPA(C1=__builtin_amdgcn_mfma_f32_32x32x16_bf16(kf[5],qr[2],C1,0,0,0),   P1[6],P1[7],P1[8],P1[9],     pw2[2]=PKW(P1,4), pw2[3]=PKW(P1,6), pw2); \
    VRD(3); SBAR(); GAPA(C0=__builtin_amdgcn_mfma_f32_32x32x16_bf16(kf[6],qr[3],C0,0,0,0),   P1[10],P1[11],P1[12],P1[13], pw3[0]=PKW(P1,8), pw3[1]=PKW(P1,10), pw3); \
    VRD(7); SBAR(); GAPA(C1=__builtin_amdgcn_mfma_f32_32x32x16_bf16(kf[7],qr[3],C1,0,0,0),   P1[14],P1[15],0.f,0.f,       pw3[2]=PKW(P1,12),pw3[3]=PKW(P1,14), pw3); \
    l_reg+=sacc; \
    if(GK){DMA_K((t)+3,sl_cur);} if(GV){DMA_V((t)+1,sl_next);} \
    CMASK(C0,C1,t); \
    { float a=MX3(C0[0],C0[1],C1[0]),b=MX3(C0[2],C0[3],C1[1]); a=MX3(a,C1[2],C1[3]); \
      _Pragma("unroll") for(int r=4;r<16;r+=4){a=MX3(a,C0[r],C0[r+1]);b=MX3(b,C0[r+2],C0[r+3]);a=MX3(a,C1[r],C1[r+1]);b=MX3(b,C1[r+2],C1[r+3]);} \
      float rm=__builtin_fmaxf(a,b); { auto rr=__builtin_amdgcn_permlane32_swap(__float_as_uint(rm),__float_as_uint(rm),false,false); rm=__builtin_fmaxf(__uint_as_float(rr[0]),__uint_as_float(rr[1])); } \
      resc=false; \
      if(__builtin_expect(__any(rm>(float)THRL),0)){ const float dl=__builtin_fmaxf(rm,0.f); mhat+=dl; \
        _Pragma("unroll") for(int r=0;r<16;++r){C0[r]-=dl;C1[r]-=dl;} \
        _Pragma("unroll") for(int r=0;r<16;++r)negm[r]=-mhat; asm volatile("":"+v"(negm)); \
        const float f=__builtin_amdgcn_exp2f(-dl); l_reg*=f; if(hi==0)wsf[r32]=f; resc=true; } } \
    SBAR(); \
    GAPB(o[0]=__builtin_amdgcn_mfma_f32_32x32x16_bf16(PAF(0),VFR(0),o[0],0,0,0), C0,0); \
    GAPB(o[1]=__builtin_amdgcn_mfma_f32_32x32x16_bf16(PAF(0),VFR(4),o[1],0,0,0), C0,4); \
    KRD(GL,0); GAPB(o[0]=__builtin_amdgcn_mfma_f32_32x32x16_bf16(PAF(1),VFR(1),o[0],0,0,0), C0,8); \
    KRD(GL,1); GAPB(o[1]=__builtin_amdgcn_mfma_f32_32x32x16_bf16(PAF(1),VFR(5),o[1],0,0,0), C0,12); \
    KRD(GL,2); GAPB(o[0]=__builtin_amdgcn_mfma_f32_32x32x16_bf16(PAF(2),VFR(2),o[0],0,0,0), C1,0); \
    KRD(GL,3); GAPB(o[1]=__builtin_amdgcn_mfma_f32_32x32x16_bf16(PAF(2),VFR(6),o[1],0,0,0), C1,4); \
    GAPB(o[0]=__builtin_amdgcn_mfma_f32_32x32x16_bf16(PAF(3),VFR(3),o[0],0,0,0), C1,8); \
    GAPB(o[1]=__builtin_amdgcn_mfma_f32_32x32x16_bf16(PAF(3),VFR(7),o[1],0,0,0), C1,12); \
    }while(0)
  int t=1;
  for(;t+5<NT;t+=2){
    STEP(pB0,pB1,pA0,pA1,t,true,true,true);     WAIT_BAR(2); RESC(); ROT();
    STEP(pA0,pA1,pB0,pB1,t+1,true,true,true);   WAIT_BAR(2); RESC(); ROT();
  }
  #define ENDW(tt) do{ if((tt)+3<NT){WAIT_BAR(2);} else if((tt)+2<NT){WAIT_BAR(1);} else {WAIT_BAR(0);} }while(0)
  for(;t+1<NT;t+=2){
    STEP(pB0,pB1,pA0,pA1,t,(t+3<NT),(t+1<NT),(t+1<NT));       ENDW(t);   RESC(); ROT();
    STEP(pA0,pA1,pB0,pB1,t+1,(t+4<NT),(t+2<NT),(t+2<NT));     ENDW(t+1); RESC(); ROT();
  }
  STEP(pB0,pB1,pA0,pA1,NT-1,false,false,false); RESC();
  { float sacc=pB0[0]+pB0[1]; _Pragma("unroll") for(int r=2;r<16;++r)sacc+=pB0[r]; _Pragma("unroll") for(int r=0;r<16;++r)sacc+=pB1[r]; l_reg+=sacc;
    pw0=(u32x4){PKW(pB0,0),PKW(pB0,2),PKW(pB0,4),PKW(pB0,6)};pw1=(u32x4){PKW(pB0,8),PKW(pB0,10),PKW(pB0,12),PKW(pB0,14)};pw2=(u32x4){PKW(pB1,0),PKW(pB1,2),PKW(pB1,4),PKW(pB1,6)};pw3=(u32x4){PKW(pB1,8),PKW(pB1,10),PKW(pB1,12),PKW(pB1,14)};
    SBAR(); pv(o,vb0+sl_cur,PAF(0),PAF(1),PAF(2),PAF(3)); }
  #undef PKW
  #undef PAF
  #undef VFR
  #undef PIN
  #undef MX3
  #undef GAPA
  #undef GAPB
  #undef EX
  #undef VRD
  #undef KRD
  #undef STEP
  #undef ENDW
  {auto rr=__builtin_amdgcn_permlane32_swap(__float_as_uint(l_reg),__float_as_uint(l_reg),false,false);l_reg=__uint_as_float(rr[0])+__uint_as_float(rr[1]);}
  if(J.has_sink)l_reg+=__builtin_amdgcn_exp2f(J.sink2-mhat);
  if(hi==0)wsf[32+r32]=l_reg;asm volatile("s_waitcnt lgkmcnt(0)":::"memory");
  float rli[16];
  #pragma unroll
  for(int r=0;r<16;++r)rli[r]=__builtin_amdgcn_rcpf(wsf[32+crow(r,hi)]);
  bf16*Ow=J.O+(long)(J.qrow0+wid*QBLK)*OP;
  { bf16*stg=(bf16*)(shm+LDS_OST)+wid*2048;
    #pragma unroll
    for(int r=0;r<16;++r){const int orow=crow(r,hi);
      #pragma unroll
      for(int d0=0;d0<2;++d0)stg[orow*64+d0*32+r32]=__float2bfloat16(o[d0][r]*rli[r]);}
    asm volatile("s_waitcnt lgkmcnt(0)":::"memory");
    #pragma unroll
    for(int i=0;i<4;++i){const int row=i*8+(lane>>3),ch=lane&7; const u32x4 v=*(const u32x4*)(stg+row*64+ch*8); ATTN_STORE16(Ow+(long)row*OP+ch*8,v);} }
  asm volatile("s_waitcnt lgkmcnt(0)\n\ts_barrier":::"memory");
  #undef DMA_K
  #undef TROW
  #undef DMA_V
  #undef CMASK
  #undef START
  #undef RESC
  #undef ROT
}
constexpr int ATTN_LDS_BYTES=LDS_BYTES;
#undef SBAR
#undef WAIT_BAR
}
#define LAS __attribute__((address_space(3)))
typedef unsigned short bf16_t;
typedef float f32x4 __attribute__((ext_vector_type(4)));
typedef unsigned u32x4 __attribute__((ext_vector_type(4)));
typedef unsigned u32x2 __attribute__((ext_vector_type(2)));
typedef float cf2 __attribute__((ext_vector_type(2)));
__device__ __forceinline__ cf2 mk2(float x, float y) { cf2 r; r.x = x; r.y = y; return r; }
constexpr int DM = 1024, NBATCH = 2, SEQ = 16384, DEPTH = 4, CTXL = 256, DFF = 2816, DIN = 2304, NMODV = 9 * 1024;
constexpr int MLAT = NBATCH * SEQ, MTOT = MLAT + NBATCH * CTXL;
constexpr int PBP = 1280;
constexpr float EPSF = 1e-6f;
constexpr float QC2 = 0.125f * 1.4426950408889634f;
constexpr float LOG2E = 1.4426950408889634f;
constexpr int NTHREADS = 512, NWAVES = 8;
constexpr int LDS_BYTES = 147456;
constexpr size_t MiB = 1u << 20;
constexpr size_t WS_MOD = 1 * MiB, WS_TW14 = 2 * MiB, WS_TW15 = 2 * MiB + 131072, WS_TWA = 2 * MiB + 262144, WS_TWB = 2 * MiB + 393216, WS_H2 = 3 * MiB, WS_H2C = 7 * MiB, WS_XC = 8 * MiB;
constexpr size_t WS_W13A = 10 * MiB, WS_W13B = 21 * MiB, WS_W2A = 32 * MiB, WS_W2B = WS_W2A + 5767168, WS_WIN = 43 * MiB, WS_WOUT = WS_WIN + 4718592, WS_WLRU = WS_WOUT + 2 * MiB;
constexpr size_t WS_XN = 50 * MiB;
constexpr size_t WS_SCR = 116 * MiB;
constexpr size_t WS_H = WS_SCR;
constexpr size_t WS_PB = WS_SCR, WS_R = 198 * MiB, WS_UT = 215 * MiB, WS_KF = 311 * MiB, WS_AB = 375 * MiB, WS_PA = WS_AB;
constexpr size_t WS_UC = 505 * MiB;
constexpr size_t WS_SUM = 507 * MiB, WS_CAR = 508 * MiB;
constexpr size_t WS_PART = 509 * MiB;
constexpr size_t WS_RAW0 = WS_KF, WS_RAW1 = 532 * MiB;
constexpr size_t WS_END = 565 * MiB;
static_assert(WS_WLRU + 524288 <= WS_XN && WS_XN + (size_t)MTOT * 1024 * 2 <= WS_SCR && WS_H + (size_t)MTOT * DFF * 2 <= WS_END, "ws map");
static_assert(WS_PB + (size_t)MTOT * PBP * 2 <= WS_R && WS_R + (size_t)MTOT * 256 * 2 <= WS_UT && WS_UT + (size_t)6 * 256 * SEQ * 4 <= WS_KF && WS_KF + (size_t)256 * 262144 <= WS_AB && WS_AB + (size_t)2 * MTOT * 256 * 8 <= WS_END, "ws map 2");

struct Args { const float* in[32]; float* out; unsigned char* ws; };
typedef const Args __attribute__((address_space(4)))* ArgsP;
__device__ __forceinline__ ArgsP args_ptr() { ArgsP p = (ArgsP)__builtin_amdgcn_kernarg_segment_ptr(); asm volatile("" : "+s"(p)); return p; }
enum { I_X = 0, I_C, I_CTX, I_CCTX, I_WMOD, I_BMOD, I_NORMG, I_F1W13, I_F1W2, I_F2W13, I_F2W2, I_WIN, I_WOUT, I_HYCW, I_HYCB, I_HYW1, I_HYB1, I_HYFREQ, I_HYW2, I_HYB2, I_HYW3, I_HYSKIP,
       I_LRUCW, I_LRUCB, I_LRUWA, I_LRUBA, I_LRUWX, I_LRUBX, I_LRULAM, I_SINK, I_QKGAIN, I_FINALG };

__device__ __forceinline__ unsigned f2bf(float f) { unsigned u = __float_as_uint(f); return (u + 0x7fffu + ((u >> 16) & 1u)) >> 16; }
__device__ __forceinline__ unsigned pk2(float lo, float hi) { return f2bf(lo) | (f2bf(hi) << 16); }
__device__ __forceinline__ float bflo(unsigned w) { return __uint_as_float(w << 16); }
__device__ __forceinline__ float bfhi(unsigned w) { return __uint_as_float(w & 0xffff0000u); }
__device__ __forceinline__ float bf2f(bf16_t h) { return __uint_as_float(((unsigned)h) << 16); }
__device__ __forceinline__ float wave_sum(float v) {
#pragma unroll
    for (int o = 1; o < 64; o <<= 1) v += __shfl_xor(v, o);
    return v;
}
__device__ __forceinline__ void unpack8(const u32x4 w, float (&v)[8]) { v[0] = bflo(w.x); v[1] = bfhi(w.x); v[2] = bflo(w.y); v[3] = bfhi(w.y); v[4] = bflo(w.z); v[5] = bfhi(w.z); v[6] = bflo(w.w); v[7] = bfhi(w.w); }
__device__ __forceinline__ u32x4 pack8(const float (&v)[8]) { u32x4 w; w.x = pg8::cvt_pk_bf16(v[0], v[1]); w.y = pg8::cvt_pk_bf16(v[2], v[3]); w.z = pg8::cvt_pk_bf16(v[4], v[5]); w.w = pg8::cvt_pk_bf16(v[6], v[7]); return w; }
__device__ __forceinline__ float* xrow_ptr(ArgsP a, int row) { return row < MLAT ? a->out + (size_t)row * DM : (float*)(a->ws + WS_XC) + (size_t)(row - MLAT) * DM; }
__device__ __forceinline__ int mod_index(int row) { return row < MLAT ? (row >> 14) : 2; }
__device__ __forceinline__ float sigmoidf_(float x) { return 1.f / (1.f + __expf(-x)); }

struct EpiSwiGLU {
    static constexpr bool PERM = true, AFTER_DRAIN = false;
    bf16_t* H;
    __device__ __forceinline__ void operator()(const pg8::f32x4 (&acc)[2][2][4][2], const pg8::Unit& u, int wr, int wc, int fr, int fq) const {
#ifndef STUB_EpiSwiGLU
        const int row0 = u.pm * 256 + wr * 64 + fr, col0 = u.pn * 128 + wc * 32 + 8 * fq;
#pragma unroll
        for (int ai = 0; ai < 2; ++ai)
#pragma unroll
            for (int m = 0; m < 4; ++m) {
                float v[8];
#pragma unroll
                for (int n = 0; n < 2; ++n)
#pragma unroll
                    for (int i = 0; i < 4; ++i) { const float g = acc[ai][0][m][n][i], up = acc[ai][1][m][n][i]; v[4 * n + i] = g * __builtin_amdgcn_rcpf(1.f + __expf(-g)) * up; }
                *(u32x4*)(H + (size_t)(row0 + ai * 128 + m * 16) * DFF + col0) = pack8(v);
            }
#endif
    }
};
struct EpiResid {
    static constexpr bool PERM = false, AFTER_DRAIN = false;
    float* Xlat; float* Xctx; const float* gate; float gs; const float* Xin;
    __device__ __forceinline__ void operator()(const pg8::f32x4 (&acc)[2][2][4][2], const pg8::Unit& u, int wr, int wc, int fr, int fq) const {
#ifndef STUB_EpiResid
        const int mi = u.pm < 128 ? (u.pm >> 6) : 2;
        float* base = u.pm < 128 ? Xlat + (size_t)u.pm * 256 * DM : Xctx + (size_t)(u.pm - 128) * 256 * DM;
        const float* rbase = u.pm < 128 ? Xin + (size_t)u.pm * 256 * DM : base;
#pragma unroll
        for (int bj = 0; bj < 2; ++bj)
#pragma unroll
            for (int n = 0; n < 2; ++n) {
                const int c = 256 * u.pn + 128 * bj + 32 * wc + 16 * n + 4 * fq;
                const f32x4 gv = *(const f32x4*)(gate + (size_t)mi * NMODV + c) * gs;
#pragma unroll
                for (int ai = 0; ai < 2; ++ai)
#pragma unroll
                    for (int m = 0; m < 4; ++m) { const size_t off = (size_t)(128 * ai + 64 * wr + 16 * m + fr) * DM + c; *(f32x4*)(base + off) = *(const f32x4*)(rbase + off) + gv * acc[ai][bj][m][n]; if (m & 1) asm volatile("" ::: "memory"); }
            }
#endif
    }
};
struct EpiResidCtxSplitK {
    static constexpr bool PERM = false, AFTER_DRAIN = false;
    float* PART; const float* gate; float gs; int nNr;
    __device__ __forceinline__ void operator()(const pg8::f32x4 (&acc)[2][2][4][2], const pg8::Unit& u, int wr, int wc, int fr, int fq) const {
        const int pn = u.pn % nNr, ks = u.pn / nNr; const int c0 = 256 * pn + 32 * wc + 4 * fq;
        f32x4 gv[2][2];
#pragma unroll
        for (int bj = 0; bj < 2; ++bj)
#pragma unroll
            for (int n = 0; n < 2; ++n) gv[bj][n] = *(const f32x4*)(gate + (size_t)2 * NMODV + c0 + 128 * bj + 16 * n) * gs;
        float* base = PART + ((size_t)ks * (NBATCH * CTXL) + u.pm * 256 + 64 * wr + fr) * DM + c0;
#pragma unroll
        for (int ai = 0; ai < 2; ++ai)
#pragma unroll
            for (int m = 0; m < 4; ++m) {
                float* p = base + (size_t)(128 * ai + 16 * m) * DM;
#pragma unroll
                for (int bj = 0; bj < 2; ++bj)
#pragma unroll
                    for (int n = 0; n < 2; ++n) *(f32x4*)(p + 128 * bj + 16 * n) = gv[bj][n] * acc[ai][bj][m][n];
            }
    }
};
struct EpiProj {
    static constexpr bool PERM = true, AFTER_DRAIN = false;
    bf16_t* PA; bf16_t* PB;
    __device__ __forceinline__ void operator()(const pg8::f32x4 (&acc)[2][2][4][2], const pg8::Unit& u, int wr, int wc, int fr, int fq) const {
#ifndef STUB_EpiProj
        bf16_t* O = u.pn < 4 ? PA : PB; const int ldc = u.pn < 4 ? 1024 : PBP; const int cb = (u.pn < 4 ? u.pn : u.pn - 4) * 256 + wc * 32 + 8 * fq;
        const int row0 = u.pm * 256 + wr * 64 + fr;
#pragma unroll
        for (int ai = 0; ai < 2; ++ai)
#pragma unroll
            for (int m = 0; m < 4; ++m)
#pragma unroll
                for (int bj = 0; bj < 2; ++bj) {
                    float v[8];
#pragma unroll
                    for (int n = 0; n < 2; ++n)
#pragma unroll
                        for (int i = 0; i < 4; ++i) v[4 * n + i] = acc[ai][bj][m][n][i];
                    *(u32x4*)(O + (size_t)(row0 + ai * 128 + m * 16) * ldc + cb + bj * 128) = pack8(v);
                }
#endif
    }
};
struct EpiLru {
    static constexpr bool PERM = true, AFTER_DRAIN = false;
    unsigned* RAW0; unsigned* RAW1;
    __device__ __forceinline__ void operator()(const pg8::f32x4 (&acc)[2][2][4][2], const pg8::Unit& u, int wr, int wc, int fr, int fq) const {
#ifndef STUB_EpiLru
        const int dir = u.pn >> 1, ch0 = (u.pn & 1) * 128 + wc * 32 + 8 * fq;
        const int row0 = u.pm * 256 + wr * 64 + fr;
        unsigned* R = dir ? RAW1 : RAW0;
#pragma unroll
        for (int ai = 0; ai < 2; ++ai)
#pragma unroll
            for (int m = 0; m < 4; ++m) {
                unsigned* o = R + (size_t)(row0 + ai * 128 + m * 16) * 256 + ch0;
#pragma unroll
                for (int n = 0; n < 2; ++n) {
                    const f32x4 pa = acc[ai][0][m][n], px = acc[ai][1][m][n];
                    u32x4 w; w.x = pg8::cvt_pk_bf16(pa[0], px[0]); w.y = pg8::cvt_pk_bf16(pa[1], px[1]); w.z = pg8::cvt_pk_bf16(pa[2], px[2]); w.w = pg8::cvt_pk_bf16(pa[3], px[3]);
                    *(u32x4*)(o + 4 * n) = w;
                }
            }
#endif
    }
};
constexpr int LCH = 130, NCH = 128;
#define LRU_ROWOF(p, b, dir) ((p) < CTXL ? (size_t)MLAT + (b) * CTXL + ((dir) ? (CTXL - 1 - (p)) : (p)) : (size_t)(b) * SEQ + ((dir) ? (SEQ - 1 - ((p) - CTXL)) : ((p) - CTXL)))
__device__ __forceinline__ void lru_gate_phase(ArgsP a, int l, int tid) {
    cf2* AB = (cf2*)(a->ws + WS_AB); const bf16_t* R = (const bf16_t*)(a->ws + WS_R); cf2* SUM = (cf2*)(a->ws + WS_SUM);
    const int ch = tid & 255, half = tid >> 8;
    for (int u = blockIdx.x; u < 256; u += gridDim.x) {
        const int dir = u >> 7, b = (u >> 6) & 1, chunk = (u & 63) * 2 + half;
        const float vba = a->in[I_LRUBA][(size_t)l * 512 + dir * 256 + ch], vbx = a->in[I_LRUBX][(size_t)l * 512 + dir * 256 + ch];
        const float sp8 = -8.f * log1pf(expf(-a->in[I_LRULAM][(size_t)l * 512 + dir * 256 + ch]));
        unsigned* ABd = (unsigned*)AB + (size_t)dir * MTOT * 256 + ch; const bf16_t* Rc = R + ch; const unsigned* RWd = (const unsigned*)(a->ws + (dir ? WS_RAW1 : WS_RAW0)) + ch;
        float Ac = 1.f, h = 0.f;
        cf2 raw[10]; float uu[10];
#pragma unroll
        for (int j = 0; j < 10; ++j) { const size_t row = LRU_ROWOF(chunk * LCH + j, b, dir); const unsigned w = RWd[row * 256]; raw[j] = mk2(bflo(w), bfhi(w)); uu[j] = bf2f(Rc[row * 256]); }
#pragma unroll 1
        for (int s0 = 0; s0 < LCH; s0 += 10) {
            cf2 rn[10]; float un[10];
            const int s1 = (s0 + 10 < LCH) ? s0 + 10 : s0;
#pragma unroll
            for (int j = 0; j < 10; ++j) { const size_t row = LRU_ROWOF(chunk * LCH + s1 + j, b, dir); const unsigned w = RWd[row * 256]; rn[j] = mk2(bflo(w), bfhi(w)); un[j] = bf2f(Rc[row * 256]); }
#pragma unroll
            for (int j = 0; j < 10; ++j) {
                const float ra = __builtin_amdgcn_rcpf(1.f + __expf(-(raw[j].x + vba))), ri = __builtin_amdgcn_rcpf(1.f + __expf(-(raw[j].y + vbx)));
                const float la = ra * sp8; const float av = __expf(la); const float bv = __builtin_amdgcn_sqrtf(fmaxf(__builtin_fmaf(-av, av, 1.0f), 0.f)) * ri * uu[j];
                h = av * h + bv; Ac *= av;
                const size_t row = LRU_ROWOF(chunk * LCH + s0 + j, b, dir); ABd[row * 256] = pg8::cvt_pk_bf16(Ac, h);
            }
#pragma unroll
            for (int j = 0; j < 10; ++j) { raw[j] = rn[j]; uu[j] = un[j]; }
        }
        SUM[((size_t)((dir * 2 + b) * NCH + chunk)) * 256 + ch] = mk2(Ac, h);
    }
}
__device__ __forceinline__ void lru_carry_unit(ArgsP a, int db, int tid) {
    if (tid < 256) {
        const cf2* SUM = (const cf2*)(a->ws + WS_SUM) + (size_t)db * NCH * 256 + tid; float* CAR = (float*)(a->ws + WS_CAR) + (size_t)db * NCH * 256 + tid;
        float c = 0.f;
#pragma unroll 1
        for (int k0 = 0; k0 < NCH; k0 += 8) {
            cf2 e[8];
#pragma unroll
            for (int j = 0; j < 8; ++j) e[j] = SUM[(size_t)(k0 + j) * 256];
#pragma unroll
            for (int j = 0; j < 8; ++j) { CAR[(size_t)(k0 + j) * 256] = c; c = e[j].x * c + e[j].y; }
        }
    }
}
typedef short sbf16x8 __attribute__((ext_vector_type(8)));
typedef float sf32x16 __attribute__((ext_vector_type(16)));
__device__ __forceinline__ int crow32(int r, int hi) { return (r & 3) + 8 * (r >> 2) + 4 * hi; }
template <int NB> __device__ __forceinline__ void wave_gemm32(const bf16_t* A, const bf16_t* B0, const bf16_t* B1, int K, int lane, sf32x16 (&acc)[NB]) {
    const int r = lane & 31, kh = lane >> 5;
    const bf16_t* pa = A + (size_t)r * K + 8 * kh; const bf16_t* pb0 = B0 + (size_t)r * K + 8 * kh; const bf16_t* pb1 = B1 + (size_t)r * K + 8 * kh;
#pragma unroll
    for (int n = 0; n < NB; ++n)
#pragma unroll
        for (int e = 0; e < 16; ++e) acc[n][e] = 0.f;
#pragma unroll 1
    for (int k = 0; k < K; k += 128) {
        sbf16x8 av[8], bv0[8], bv1[8];
#pragma unroll
        for (int j = 0; j < 8; ++j) { av[j] = *(const sbf16x8*)(pa + k + 16 * j); bv0[j] = *(const sbf16x8*)(pb0 + k + 16 * j); if (NB == 2) bv1[j] = *(const sbf16x8*)(pb1 + k + 16 * j); }
#pragma unroll
        for (int j = 0; j < 8; ++j) { acc[0] = __builtin_amdgcn_mfma_f32_32x32x16_bf16(av[j], bv0[j], acc[0], 0, 0, 0); if (NB == 2) acc[NB - 1] = __builtin_amdgcn_mfma_f32_32x32x16_bf16(av[j], bv1[j], acc[NB - 1], 0, 0, 0); }
    }
}
template <int KIND> __device__ __forceinline__ void ctx_gemm(ArgsP a, const bf16_t* A, const bf16_t* Bt, int K, int ncb, const float* gate, float gs, int tid) {
    const int lane = tid & 63, wave = tid >> 6, hi = lane >> 5, c = lane & 31;
    const int gw = blockIdx.x * NWAVES + wave, NGW = gridDim.x * NWAVES;
    unsigned char* ws = a->ws;
    for (int wt = gw; wt < 16 * ncb; wt += NGW) {
        const int cb = wt >> 4, rb = wt & 15; const int row0 = MLAT + 32 * rb;
        const bf16_t* Ar = A + (size_t)row0 * K;
        if (KIND == 0) {
            const int f0 = 32 * cb; const bf16_t* B0 = Bt + (size_t)(256 * (f0 >> 7) + (f0 & 127)) * K;
            sf32x16 acc[2]; wave_gemm32<2>(Ar, B0, B0 + (size_t)128 * K, K, lane, acc);
            bf16_t* H = (bf16_t*)(ws + WS_H);
#pragma unroll
            for (int r = 0; r < 16; ++r) { const float g = acc[0][r], up = acc[1][r]; H[(size_t)(row0 + crow32(r, hi)) * DFF + f0 + c] = (bf16_t)f2bf(g * __builtin_amdgcn_rcpf(1.f + __expf(-g)) * up); }
        } else if (KIND == 1) {
            const int col = 32 * cb + c; const bf16_t* B0 = Bt + (size_t)(32 * cb) * K;
            sf32x16 acc[1]; wave_gemm32<1>(Ar, B0, B0, K, lane, acc);
            float* X = (float*)(ws + WS_XC); const float gv = gs * gate[(size_t)2 * NMODV + col];
#pragma unroll
            for (int r = 0; r < 16; ++r) { float* p = X + (size_t)(32 * rb + crow32(r, hi)) * DM + col; *p = *p + gv * acc[0][r]; }
        } else if (KIND == 2) {
            const int col0 = 32 * cb; const bf16_t* B0 = Bt + (size_t)col0 * K;
            sf32x16 acc[1]; wave_gemm32<1>(Ar, B0, B0, K, lane, acc);
            bf16_t* O = col0 < 1024 ? (bf16_t*)(ws + WS_PA) + col0 + c : (bf16_t*)(ws + WS_PB) + (col0 - 1024) + c; const int ldc = col0 < 1024 ? 1024 : PBP;
#pragma unroll
            for (int r = 0; r < 16; ++r) O[(size_t)(row0 + crow32(r, hi)) * ldc] = (bf16_t)f2bf(acc[0][r]);
        } else {
            const int dir = cb >> 3, ch0 = (cb & 7) * 32, pn = dir * 2 + (ch0 >> 7); const bf16_t* B0 = Bt + (size_t)(256 * pn + (ch0 & 127)) * K;
            sf32x16 acc[2]; wave_gemm32<2>(Ar, B0, B0 + (size_t)128 * K, K, lane, acc);
            cf2* AB = (cf2*)(ws + WS_AB) + (size_t)dir * MTOT * 256 + ch0 + c;
#pragma unroll
            for (int r = 0; r < 16; ++r) AB[(size_t)(row0 + crow32(r, hi)) * 256] = mk2(acc[0][r], acc[1][r]);
        }
    }
}
#define XB_TMO      128
#define XB_XCNT(j)  (256  + 64 * (j))
#define XB_XSUB(j)  (1280 + 64 * (j))
#define XB_XGEN(j)  (2304 + 64 * (j))
#define XB_TOP      3328
#define XB_TOPGEN   3392
#define XCD_BAR_WORDS 3456
#define XB_SPIN_CAP (1u << 18)

__device__ __forceinline__ unsigned xb_ld(unsigned* p)              { return __hip_atomic_load(p, __ATOMIC_RELAXED, __HIP_MEMORY_SCOPE_AGENT); }
__device__ __forceinline__ unsigned xb_add(unsigned* p, unsigned v) { return __hip_atomic_fetch_add(p, v, __ATOMIC_RELAXED, __HIP_MEMORY_SCOPE_AGENT); }
__device__ __forceinline__ unsigned xb_xcc_id() { return (unsigned)__builtin_amdgcn_s_getreg((3 << 11) | 20) & 0xFu; }
#define XB_SPIN(cond, bar) do { unsigned _sp = 0; while (cond) { __builtin_amdgcn_s_sleep(1); \
    if ((++_sp & 255u) == 0u) { if (xb_ld(&(bar)[XB_TMO])) break; if (_sp > XB_SPIN_CAP) { atomicAdd(&(bar)[XB_TMO], 1u); break; } } } } while (0)

struct XcdBarrier {
    unsigned* bar; unsigned x;
    volatile LAS unsigned* st;
};

__device__ __forceinline__ XcdBarrier xcd_barrier_post(unsigned* bar, volatile LAS unsigned* st) {
    XcdBarrier b; b.bar = bar; b.x = xb_xcc_id(); b.st = st;
    if (threadIdx.x == 0) (void)xb_add(&bar[XB_XCNT(b.x)], 1u);
    return b;
}
__device__ __forceinline__ void xcd_barrier_complete(unsigned* bar, unsigned x, unsigned& nloc, unsigned& nx) {
    const unsigned G = gridDim.x * gridDim.y * gridDim.z;
    unsigned sum, cnt, mine, sp = 0u;
    for (;;) {
        sum = 0u; cnt = 0u; mine = 0u;
#pragma unroll
        for (unsigned j = 0; j < 16; ++j) { const unsigned c = xb_ld(&bar[XB_XCNT(j)]); sum += c; cnt += (c > 0u) ? 1u : 0u; mine = (j == x) ? c : mine; }
        if (sum == G) break;
        __builtin_amdgcn_s_sleep(1);
        if ((++sp & 255u) == 0u) { if (xb_ld(&bar[XB_TMO])) break; if (sp > XB_SPIN_CAP) { atomicAdd(&bar[XB_TMO], 1u); break; } }
    }
    nloc = mine > 0u ? mine : 1u; nx = cnt > 0u ? cnt : 1u;
}

__device__ __forceinline__ void xcd_barrier(const XcdBarrier& b) {
    asm volatile("s_waitcnt vmcnt(0)" ::: "memory");
    __syncthreads();
    if (threadIdx.x == 0) {
        unsigned* bar = b.bar;
        __builtin_amdgcn_s_waitcnt(0);
        unsigned nloc = b.st[0], nx = b.st[1];
        if (nloc == 0u) { xcd_barrier_complete(bar, b.x, nloc, nx); b.st[0] = nloc; b.st[1] = nx; }
        const unsigned old = xb_add(&bar[XB_XSUB(b.x)], 1u);
        const unsigned gen = old / nloc;
        if (old + 1u == (gen + 1u) * nloc) {
            __builtin_amdgcn_fence(__ATOMIC_RELEASE, "agent");
            asm volatile("s_waitcnt vmcnt(0)" ::: "memory");
            const unsigned og = xb_add(&bar[XB_TOP], 1u);
            const unsigned tg = og / nx;
            if (og + 1u == (tg + 1u) * nx) xb_add(&bar[XB_TOPGEN], 1u);
            else XB_SPIN(xb_ld(&bar[XB_TOPGEN]) == tg, bar);
            __builtin_amdgcn_fence(__ATOMIC_ACQUIRE, "agent");
            xb_add(&bar[XB_XGEN(b.x)], 1u);
            asm volatile("s_waitcnt vmcnt(0)" ::: "memory");
        } else {
            XB_SPIN(xb_ld(&bar[XB_XGEN(b.x)]) == gen, bar);
            __builtin_amdgcn_fence(__ATOMIC_ACQUIRE, "agent");
            asm volatile("s_waitcnt vmcnt(0)" ::: "memory");
        }
    }
    __syncthreads();
}
__device__ __forceinline__ void transpose_item(const float* W, int K, int N, bf16_t* WT, int k0, int n0, int drow0, LAS float* scr, int lane) {
#pragma unroll 8
    for (int i = 0; i < 32; ++i) { const int kk = 2 * i + (lane >> 5); scr[kk * 33 + (lane & 31)] = W[(size_t)(k0 + kk) * N + n0 + (lane & 31)]; }
    asm volatile("s_waitcnt lgkmcnt(0)" ::: "memory");
    const int c = lane & 7;
#pragma unroll
    for (int j = 0; j < 4; ++j) { const int n = (lane >> 3) + 8 * j; const LAS float* s = scr + (8 * c) * 33 + n;
        u32x4 o; o.x = pk2(s[0 * 33], s[1 * 33]); o.y = pk2(s[2 * 33], s[3 * 33]); o.z = pk2(s[4 * 33], s[5 * 33]); o.w = pk2(s[6 * 33], s[7 * 33]);
        *(u32x4*)(WT + (size_t)(drow0 + n) * K + k0 + 8 * c) = o; }
    asm volatile("s_waitcnt lgkmcnt(0)" ::: "memory");
}
__device__ __forceinline__ int w13_drow(int c) { return c < DFF ? 256 * (c >> 7) + (c & 127) : 256 * ((c - DFF) >> 7) + 128 + ((c - DFF) & 127); }

__device__ __forceinline__ void h2_row(ArgsP a, int l, int t, int n, float* dst, size_t dstride, int lane) {
    const float tt = (float)t / (float)(n - 1);
    const float w = (float)(2.0 * 3.14159265358979323846) * (float)t / (float)n;
    float z = 0.f;
    if (lane == 0) z = tt;
    else if (lane <= 16) { const float f = 1e-4f + (float)(lane - 1) * ((15.0f - 1e-4f) / 15.0f); z = cosf(f * w); }
    else if (lane <= 32) { const float f = 1e-4f + (float)(lane - 17) * ((15.0f - 1e-4f) / 15.0f); z = -sinf(f * w); }
    const float* w1 = a->in[I_HYW1] + (size_t)l * 33 * 64; const float* w2 = a->in[I_HYW2] + (size_t)l * 64 * 64;
    float h1 = a->in[I_HYB1][l * 64 + lane];
#pragma unroll
    for (int i = 0; i < 33; ++i) h1 += __shfl(z, i) * w1[i * 64 + lane];
    h1 = sinf(a->in[I_HYFREQ][(l * 2 + 0) * 64 + lane] * h1);
    float h2 = a->in[I_HYB2][l * 64 + lane];
#pragma unroll 8
    for (int i = 0; i < 64; ++i) h2 += __shfl(h1, i) * w2[i * 64 + lane];
    h2 = sinf(a->in[I_HYFREQ][(l * 2 + 1) * 64 + lane] * h2);
    dst[(size_t)lane * dstride] = h2;
}

__device__ __forceinline__ void prep_layer(ArgsP a, int l, LAS unsigned char* lds, int tid, int wave, int lane) {
    LAS float* scr = (LAS float*)(lds + wave * 16384);
    const int gw = blockIdx.x * NWAVES + wave, NGW = gridDim.x * NWAVES;
    unsigned char* ws = a->ws;
    constexpr int I13 = 16 * 176, I2 = 44 * 32, IIN = 16 * 72, IOUT = 16 * 32, NIT = 2 * I13 + 2 * I2 + IIN + IOUT;
    for (int it = gw; it < NIT; it += NGW) {
        int r = it;
        if (r < 2 * I13) { const int w = r / I13; r -= w * I13; const int kb = r / 176, nb = r % 176;
            transpose_item((w ? a->in[I_F2W13] : a->in[I_F1W13]) + (size_t)l * DM * 2 * DFF, DM, 2 * DFF, (bf16_t*)(ws + (w ? WS_W13B : WS_W13A)), 64 * kb, 32 * nb, w13_drow(32 * nb), scr, lane); continue; }
        r -= 2 * I13;
        if (r < 2 * I2) { const int w = r / I2; r -= w * I2; const int kb = r / 32, nb = r % 32;
            transpose_item((w ? a->in[I_F2W2] : a->in[I_F1W2]) + (size_t)l * DFF * DM, DFF, DM, (bf16_t*)(ws + (w ? WS_W2B : WS_W2A)), 64 * kb, 32 * nb, 32 * nb, scr, lane); continue; }
        r -= 2 * I2;
        if (r < IIN) { const int kb = r / 72, nb = r % 72; transpose_item(a->in[I_WIN] + (size_t)l * DM * DIN, DM, DIN, (bf16_t*)(ws + WS_WIN), 64 * kb, 32 * nb, 32 * nb, scr, lane); continue; }
        r -= IIN;
        { const int kb = r / 32, nb = r % 32; transpose_item(a->in[I_WOUT] + (size_t)l * DM * DM, DM, DM, (bf16_t*)(ws + WS_WOUT), 64 * kb, 32 * nb, 32 * nb, scr, lane); }
    }
    {
        bf16_t* WL = (bf16_t*)(ws + WS_WLRU);
        const int gt = blockIdx.x * NTHREADS + tid, NGT = gridDim.x * NTHREADS;
        for (int idx = gt; idx < 1024 * 32; idx += NGT) {
            const int np = idx >> 5, k0 = (idx & 31) * 8; const int pn = np >> 8, j = np & 255, dir = pn >> 1, mat = j >> 7, ch = (pn & 1) * 128 + (j & 127), blk = ch >> 6, e = ch & 63;
            float v[8];
            const float* src = (mat ? a->in[I_LRUWX] : a->in[I_LRUWA]) + ((((size_t)l * 2 + dir) * 4 + blk) * 64) * 64 + e;
#pragma unroll
            for (int i = 0; i < 8; ++i) { const int k = k0 + i; v[i] = ((k >> 6) == blk) ? src[(size_t)(k & 63) * 64] : 0.f; }
            *(u32x4*)(WL + (size_t)np * 256 + k0) = pack8(v);
        }
    }
    {
        float* H2 = (float*)(ws + WS_H2); float* H2C = (float*)(ws + WS_H2C);
        for (int t = gw; t < SEQ + CTXL; t += NGW) { if (t < SEQ) h2_row(a, l, t, SEQ, H2 + t, SEQ, lane); else h2_row(a, l, t - SEQ, CTXL, H2C + (size_t)(t - SEQ) * 64, 1, lane); }
    }
}

__device__ __forceinline__ void norm_phase(ArgsP a, int l, int k, int wave, int lane, int nsplit = 0, bool from_input = false) {
    const int gw = blockIdx.x * NWAVES + wave, NGW = gridDim.x * NWAVES;
    const float* g = a->in[I_NORMG] + ((size_t)l * 3 + k) * DM; const float* MOD = (const float*)(a->ws + WS_MOD) + (size_t)l * 3 * NMODV;
    bf16_t* XN = (bf16_t*)(a->ws + WS_XN);
    f32x4 gv[4];
#pragma unroll
    for (int j = 0; j < 4; ++j) gv[j] = *(const f32x4*)(g + 4 * lane + 256 * j);
    for (int row = gw; row < MTOT; row += NGW) {
        const float* xr = (from_input && row < MLAT) ? a->in[I_X] + (size_t)row * DM : xrow_ptr(a, row); const int mi = mod_index(row);
        const float* sh = MOD + (size_t)mi * NMODV + (3 * k) * DM; const float* sc = sh + DM;
        f32x4 v[4]; float s = 0.f;
#pragma unroll
        for (int j = 0; j < 4; ++j) v[j] = *(const f32x4*)(xr + 4 * lane + 256 * j);
        if (nsplit > 0 && row >= MLAT) {
            const float* pp = (const float*)(a->ws + WS_PART) + (size_t)(row - MLAT) * DM + 4 * lane;
            for (int ks = 0; ks < nsplit; ++ks) {
#pragma unroll
                for (int j = 0; j < 4; ++j) v[j] = v[j] + *(const f32x4*)(pp + (size_t)ks * (NBATCH * CTXL) * DM + 256 * j);
            }
            float* xw = (float*)xr;
#pragma unroll
            for (int j = 0; j < 4; ++j) *(f32x4*)(xw + 4 * lane + 256 * j) = v[j];
        }
#pragma unroll
        for (int j = 0; j < 4; ++j) s += (v[j].x * v[j].x + v[j].y * v[j].y) + (v[j].z * v[j].z + v[j].w * v[j].w);
        const float rs = rsqrtf(wave_sum(s) * (1.f / DM) + EPSF);
#pragma unroll
        for (int j = 0; j < 4; ++j) {
            const f32x4 scv = *(const f32x4*)(sc + 4 * lane + 256 * j), shv = *(const f32x4*)(sh + 4 * lane + 256 * j);
            const f32x4 y = v[j] * rs * gv[j] * (scv + 1.f) + shv;
            u32x2 o; o.x = pk2(y.x, y.y); o.y = pk2(y.z, y.w);
            *(u32x2*)(XN + (size_t)row * DM + 4 * lane + 256 * j) = o;
        }
    }
}
__device__ __forceinline__ void final_norm_phase(ArgsP a, int wave, int lane) {
    const int gw = blockIdx.x * NWAVES + wave, NGW = gridDim.x * NWAVES;
    const float* g = a->in[I_FINALG];
    for (int row = gw; row < MLAT; row += NGW) {
        float* xr = a->out + (size_t)row * DM;
        f32x4 v[4]; float s = 0.f;
#pragma unroll
        for (int j = 0; j < 4; ++j) { v[j] = *(const f32x4*)(xr + 4 * lane + 256 * j); s += (v[j].x * v[j].x + v[j].y * v[j].y) + (v[j].z * v[j].z + v[j].w * v[j].w); }
        const float rs = rsqrtf(wave_sum(s) * (1.f / DM) + EPSF);
#pragma unroll
        for (int j = 0; j < 4; ++j) *(f32x4*)(xr + 4 * lane + 256 * j) = v[j] * rs * *(const f32x4*)(g + 4 * lane + 256 * j);
    }
}

__device__ __forceinline__ void prologue_phase(ArgsP a, LAS unsigned char* lds, int tid, int wave, int lane) {
    const int gt = blockIdx.x * NTHREADS + tid, NGT = gridDim.x * NTHREADS;
    cf2* T14 = (cf2*)(a->ws + WS_TW14); cf2* T15 = (cf2*)(a->ws + WS_TW15);
    for (int k = gt; k < 16384; k += NGT) { float s, c; sincospif((float)k * (1.0f / 8192.0f), &s, &c); T14[k] = mk2(c, -s); sincospif((float)k * (1.0f / 16384.0f), &s, &c); T15[k] = mk2(c, -s); }
    { const f32x4* src = (const f32x4*)a->in[I_CTX]; f32x4* dst = (f32x4*)(a->ws + WS_XC); for (int i = gt; i < NBATCH * CTXL * DM / 4; i += NGT) dst[i] = src[i]; }
    LAS float* sc = (LAS float*)lds; LAS float* part = sc + 3 * DM;
    for (int i = tid; i < 3 * DM; i += NTHREADS) { const int mi = i >> 10, k = i & 1023; const float c = mi < 2 ? a->in[I_C][mi * DM + k] : a->in[I_CCTX][k]; sc[i] = c / (1.f + expf(-c)); }
    __syncthreads();
    float* MOD = (float*)(a->ws + WS_MOD);
    for (int u = blockIdx.x; u < DEPTH * 36; u += gridDim.x) {
        const int l = u / 36, n = (u % 36) * 256 + (tid & 255), kh = tid >> 8;
        const float* w = a->in[I_WMOD] + ((size_t)l * DM + kh * 512) * NMODV + n;
        float a0 = 0.f, a1 = 0.f, a2 = 0.f;
#pragma unroll 8
        for (int k = 0; k < 512; ++k) { const float wv = w[(size_t)k * NMODV]; a0 += sc[kh * 512 + k] * wv; a1 += sc[DM + kh * 512 + k] * wv; a2 += sc[2 * DM + kh * 512 + k] * wv; }
        if (kh == 1) { part[tid & 255] = a0; part[256 + (tid & 255)] = a1; part[512 + (tid & 255)] = a2; }
        __syncthreads();
        if (kh == 0) { const float b = a->in[I_BMOD][l * NMODV + n];
            MOD[((size_t)l * 3 + 0) * NMODV + n] = a0 + part[tid] + b; MOD[((size_t)l * 3 + 1) * NMODV + n] = a1 + part[256 + tid] + b; MOD[((size_t)l * 3 + 2) * NMODV + n] = a2 + part[512 + tid] + b; }
        __syncthreads();
    }
}

__device__ __forceinline__ void e1_phase(ArgsP a, int l, LAS unsigned char* lds, int tid, int wave, int lane) {
    const int gw = blockIdx.x * NWAVES + wave, NGW = gridDim.x * NWAVES;
    const int gt = blockIdx.x * NTHREADS + tid, NGT = gridDim.x * NTHREADS;
    bf16_t* PB = (bf16_t*)(a->ws + WS_PB); const bf16_t* PA = (const bf16_t*)(a->ws + WS_PA); bf16_t* R = (bf16_t*)(a->ws + WS_R); float* UT = (float*)(a->ws + WS_UT);
    {
        const float* gain = a->in[I_QKGAIN] + l * 128;
        const int p = lane & 31, hw = lane >> 5;
        const float invf = exp2f(-(float)(p & 15) * (13.287712379549449f / 16.f));
        const float g0a = gain[p], g0b = gain[32 + p], g1a = gain[64 + p], g1b = gain[96 + p];
        for (int row = gw; row < MTOT; row += NGW) {
            float cs = 1.f, sn = 0.f;
            if (row < MLAT) { const int t = row & (SEQ - 1); const float pos = (p < 16) ? (float)(t >> 6) : (float)(t & 63); sincosf(pos * invf, &sn, &cs); }
            bf16_t* pr = PB + (size_t)row * PBP;
#pragma unroll
            for (int i = 0; i < 6; ++i) {
                const int hd = 2 * i + hw; const int col = hd < 6 ? 256 + 64 * hd : 768 + 64 * (hd - 6);
                float z1 = bf2f(pr[col + p]), z2 = bf2f(pr[col + 32 + p]);
                if (i >= 3) {
                    float ss = z1 * z1 + z2 * z2;
#pragma unroll
                    for (int o = 1; o < 32; o <<= 1) ss += __shfl_xor(ss, o);
                    const float r = rsqrtf(ss * (1.f / 64.f) + EPSF);
                    z1 *= r * (i >= 5 ? g1a : g0a); z2 *= r * (i >= 5 ? g1b : g0b);
                }
                float o1 = z1 * cs - z2 * sn, o2 = z1 * sn + z2 * cs;
                if (i < 2 || i == 3 || i == 4) { o1 *= QC2; o2 *= QC2; }
                pr[col + p] = (bf16_t)f2bf(o1); pr[col + 32 + p] = (bf16_t)f2bf(o2);
            }
        }
    }
    {
        const float* cw = a->in[I_LRUCW] + (size_t)l * 4 * 256; const float* cb = a->in[I_LRUCB] + (size_t)l * 256;
        for (int idx = gt; idx < MTOT * 32; idx += NGT) {
            const int row = idx >> 5, ch0 = (idx & 31) * 8; const bool lat = row < MLAT; const int pos = lat ? (row & (SEQ - 1)) : ((row - MLAT) & (CTXL - 1)); const int len = lat ? SEQ : CTXL;
            float acc[8];
#pragma unroll
            for (int i = 0; i < 8; ++i) acc[i] = cb[ch0 + i];
#pragma unroll
            for (int k = 0; k < 4; ++k) { const int pp = pos + k - 2; if (pp >= 0 && pp < len) { float v[8]; unpack8(*(const u32x4*)(PA + (size_t)(row + k - 2) * 1024 + 768 + ch0), v);
#pragma unroll
                for (int i = 0; i < 8; ++i) acc[i] += cw[k * 256 + ch0 + i] * v[i]; } }
            *(u32x4*)(R + (size_t)row * 256 + ch0) = pack8(acc);
        }
    }
    {
        const float* cw = a->in[I_HYCW] + (size_t)l * 3 * 768; const float* cb = a->in[I_HYCB] + (size_t)l * 768; float* UC = (float*)(a->ws + WS_UC);
        for (int idx = gt; idx < NBATCH * CTXL * 768; idx += NGT) {
            const int c = idx % 768, bt = idx / 768, t = bt & (CTXL - 1), b = bt >> 8; const size_t row = (size_t)MLAT + bt;
            float acc = cb[c];
#pragma unroll
            for (int k = 0; k < 3; ++k) { const int tt = t + k - 1; if (tt >= 0 && tt < CTXL) acc += cw[k * 768 + c] * bf2f(PA[(row + k - 1) * 1024 + c]); }
            const int p = c >> 8, ch = c & 255;
            UC[((size_t)(p * 2 + b) * 256 + ch) * 256 + t] = acc;
        }
    }
    {
        const float* cw = a->in[I_HYCW] + (size_t)l * 3 * 768; const float* cb = a->in[I_HYCB] + (size_t)l * 768;
        LAS float* T = (LAS float*)lds; const int cgp = tid & 31, tr = tid >> 5;
        for (int u = blockIdx.x; u < 512 * 3; u += gridDim.x) {
            const int tile = u / 3, plane = u % 3, b = tile >> 8, t0 = (tile & 255) * 64; const int cc = plane * 256 + 8 * cgp;
            float wk[3][8], bb[8];
#pragma unroll
            for (int i = 0; i < 8; ++i) { bb[i] = cb[cc + i]; wk[0][i] = cw[cc + i]; wk[1][i] = cw[768 + cc + i]; wk[2][i] = cw[1536 + cc + i]; }
#pragma unroll
            for (int it = 0; it < 4; ++it) {
                const int tl = tr + 16 * it, t = t0 + tl; const size_t row = (size_t)b * SEQ + t;
                float acc[8];
#pragma unroll
                for (int i = 0; i < 8; ++i) acc[i] = bb[i];
#pragma unroll
                for (int k = 0; k < 3; ++k) { const int tt = t + k - 1; if (tt >= 0 && tt < SEQ) { float v[8]; unpack8(*(const u32x4*)(PA + (row + k - 1) * 1024 + cc), v);
#pragma unroll
                    for (int i = 0; i < 8; ++i) acc[i] += wk[k][i] * v[i]; } }
#pragma unroll
                for (int i = 0; i < 8; ++i) T[(8 * cgp + i) * 65 + tl] = acc[i];
            }
            __syncthreads();
            for (int c = wave; c < 256; c += NWAVES) UT[((size_t)(plane * 2 + b) * 256 + c) * SEQ + t0 + lane] = T[c * 65 + lane];
            __syncthreads();
        }
    }
}

__device__ __forceinline__ void e2_phase(ArgsP a, LAS unsigned char* lds, int tid, int wave, int lane) {
    const int gt = blockIdx.x * NTHREADS + tid, NGT = gridDim.x * NTHREADS;
    const bf16_t* PB = (const bf16_t*)(a->ws + WS_PB); const float* UT = (const float*)(a->ws + WS_UT); bf16_t* Y = (bf16_t*)(a->ws + WS_XN); const cf2* AB = (const cf2*)(a->ws + WS_AB);
    LAS float* T = (LAS float*)lds; const int cgp = tid & 31, tr = tid >> 5;
    for (int u = blockIdx.x; u < 512; u += gridDim.x) {
        const int b = u >> 8, t0 = (u & 255) * 64;
        for (int c = wave; c < 256; c += NWAVES) T[c * 65 + lane] = UT[((size_t)b * 256 + c) * SEQ + t0 + lane];
        __syncthreads();
#pragma unroll
        for (int it = 0; it < 4; ++it) { const int tl = tr + 16 * it; float v[8];
#pragma unroll
            for (int i = 0; i < 8; ++i) v[i] = T[(8 * cgp + i) * 65 + tl];
            *(u32x4*)(Y + ((size_t)b * SEQ + t0 + tl) * DM + 8 * cgp) = pack8(v); }
        __syncthreads();
    }
    const float* CAR = (const float*)(a->ws + WS_CAR);
    for (int idx = gt; idx < MTOT * 32; idx += NGT) {
        const int row = idx >> 5, ch0 = (idx & 31) * 8;
        float g[8]; unpack8(*(const u32x4*)(PB + (size_t)row * PBP + ch0), g);
        const unsigned* h0p = (const unsigned*)AB + (size_t)row * 256 + ch0; const unsigned* h1p = (const unsigned*)AB + ((size_t)MTOT + row) * 256 + ch0;
        const u32x4 q0a = *(const u32x4*)h0p, q0b = *(const u32x4*)(h0p + 4), q1a = *(const u32x4*)h1p, q1b = *(const u32x4*)(h1p + 4);
        const unsigned h0[8] = {q0a.x, q0a.y, q0a.z, q0a.w, q0b.x, q0b.y, q0b.z, q0b.w}, h1[8] = {q1a.x, q1a.y, q1a.z, q1a.w, q1b.x, q1b.y, q1b.z, q1b.w};
        int b, p0, p1;
        if (row < MLAT) { b = row >> 14; const int t = row & (SEQ - 1); p0 = CTXL + t; p1 = CTXL + (SEQ - 1 - t); }
        else { b = (row - MLAT) >> 8; const int j = (row - MLAT) & (CTXL - 1); p0 = j; p1 = CTXL - 1 - j; }
        const float* c0 = CAR + ((size_t)((0 * 2 + b) * NCH + p0 / LCH)) * 256 + ch0; const float* c1 = CAR + ((size_t)((1 * 2 + b) * NCH + p1 / LCH)) * 256 + ch0;
        float v[8];
#pragma unroll
        for (int i = 0; i < 8; ++i) { const float x = g[i]; const float uu = 0.7978845608028654f * (x + 0.044715f * x * x * x); const float th = 1.f - 2.f / (__expf(2.f * uu) + 1.f);
            v[i] = 0.5f * x * (1.f + th) * ((bfhi(h0[i]) + bflo(h0[i]) * c0[i]) + (bfhi(h1[i]) + bflo(h1[i]) * c1[i])); }
        *(u32x4*)(Y + (size_t)row * DM + 256 + ch0) = pack8(v);
    }
}
__device__ __forceinline__ cf2 cmul(cf2 a, cf2 b) { return mk2(a.x * b.x - a.y * b.y, a.x * b.y + a.y * b.x); }
__device__ __forceinline__ cf2 cmulc(cf2 a, cf2 b) { return mk2(a.x * b.x + a.y * b.y, a.y * b.x - a.x * b.y); }
constexpr int FN = 16384;
__device__ __forceinline__ void fft_fwd(LAS cf2* C, const cf2* __restrict__ TW, int tid) {
    for (int lh = 13; lh >= 0; --lh) {
        const int h = 1 << lh;
#pragma unroll 4
        for (int i = tid; i < FN / 2; i += NTHREADS) {
            const int j = i & (h - 1), p0 = ((i >> lh) << (lh + 1)) + j, p1 = p0 + h;
            const cf2 x = C[p0], y = C[p1], w = TW[j << (13 - lh)];
            C[p0] = mk2(x.x + y.x, x.y + y.y);
            C[p1] = cmul(mk2(x.x - y.x, x.y - y.y), w);
        }
        __syncthreads();
    }
}
__device__ __forceinline__ void fft_inv(LAS cf2* C, const cf2* __restrict__ TW, int tid) {
    for (int lh = 0; lh <= 13; ++lh) {
        const int h = 1 << lh;
#pragma unroll 4
        for (int i = tid; i < FN / 2; i += NTHREADS) {
            const int j = i & (h - 1), p0 = ((i >> lh) << (lh + 1)) + j, p1 = p0 + h;
            const cf2 x = C[p0], y = cmulc(C[p1], TW[j << (13 - lh)]);
            C[p0] = mk2(x.x + y.x, x.y + y.y);
            C[p1] = mk2(x.x - y.x, x.y - y.y);
        }
        __syncthreads();
    }
}
__device__ __forceinline__ float block_sum(float v, LAS float* red, int tid, int wave, int lane) {
    v = wave_sum(v);
    __syncthreads();
    if (lane == 0) red[wave] = v;
    __syncthreads();
    float t = 0.f;
#pragma unroll
    for (int i = 0; i < NWAVES; ++i) t += red[i];
    return t;
}
constexpr float HY_MIN_DECAY = -3.0701134573253946f, HY_MAX_DECAY = -15.350567286626973f;

constexpr int CPAD = 17920;
#define PH(p) ((p) + ((p) >> 4) + (((p) >> 9) << 4))
struct TwC { float c[9]; };
__device__ __forceinline__ TwC make_twc() {
    TwC t; t.c[0] = 1.f; t.c[1] = 0.980785280f; t.c[2] = 0.923879533f; t.c[3] = 0.831469612f; t.c[4] = 0.707106781f; t.c[5] = 0.555570233f; t.c[6] = 0.382683432f; t.c[7] = 0.195090322f; t.c[8] = 0.f;
#pragma unroll
    for (int k = 1; k < 8; ++k) asm volatile("" : "+v"(t.c[k]));
    return t;
}
#define TWC_COS(W, m) ((m) <= 8 ? (W).c[(m)] : -(W).c[16 - (m)])
#define TWC_SIN(W, m) ((m) <= 8 ? (W).c[8 - (m)] : (W).c[(m) - 8])
template <int R, bool HASB> __device__ __forceinline__ void dif_regs(cf2 (&x)[R], const TwC& W, const cf2 (&B)[5]) {
    constexpr int LOGR = (R == 32) ? 5 : 4;
#pragma unroll
    for (int st = 0; st < LOGR; ++st) {
        const int d = (R / 2) >> st;
#pragma unroll
        for (int i = 0; i < R; ++i) if ((i & d) == 0) {
            const int m = (i & (d - 1)) * (16 / d);
            const cf2 a = x[i], b = x[i + d];
            x[i] = mk2(a.x + b.x, a.y + b.y); float tx = a.x - b.x, ty = a.y - b.y;
            if (m == 8) { const float u = tx; tx = ty; ty = -u; }
            else if (m != 0) { const float c = TWC_COS(W, m), s = TWC_SIN(W, m); const float u = tx * c + ty * s; ty = ty * c - tx * s; tx = u; }
            if (HASB) { const float u = tx * B[st].x - ty * B[st].y; ty = tx * B[st].y + ty * B[st].x; tx = u; }
            x[i + d] = mk2(tx, ty);
        }
        __builtin_amdgcn_sched_barrier(0);
    }
}
template <int R, bool HASB> __device__ __forceinline__ void dit_regs(cf2 (&x)[R], const TwC& W, const cf2 (&B)[5]) {
    constexpr int LOGR = (R == 32) ? 5 : 4;
#pragma unroll
    for (int st = LOGR - 1; st >= 0; --st) {
        const int d = (R / 2) >> st;
#pragma unroll
        for (int i = 0; i < R; ++i) if ((i & d) == 0) {
            const int m = (i & (d - 1)) * (16 / d);
            const cf2 a = x[i], b = x[i + d]; float bx = b.x, by = b.y;
            if (HASB) { const float u = bx * B[st].x + by * B[st].y; by = by * B[st].x - bx * B[st].y; bx = u; }
            if (m == 8) { const float u = bx; bx = -by; by = u; }
            else if (m != 0) { const float c = TWC_COS(W, m), s = TWC_SIN(W, m); const float u = bx * c - by * s; by = by * c + bx * s; bx = u; }
            x[i] = mk2(a.x + bx, a.y + by); x[i + d] = mk2(a.x - bx, a.y - by);
        }
        __builtin_amdgcn_sched_barrier(0);
    }
}
struct FftCtx { LAS cf2* C; const cf2* T14; int tid; };
template <bool INV> __device__ __forceinline__ void pass1(const FftCtx& F_) {
    FftCtx F = F_; asm volatile("" : "+v"(F.tid)); const TwC W = make_twc();
    cf2 x[32], B[5];
#pragma unroll
    for (int s = 0; s < 5; ++s) B[s] = F.T14[F.tid << s];
#pragma unroll
    for (int i = 0; i < 32; ++i) x[i] = F.C[PH(512 * i + F.tid)];
    __builtin_amdgcn_sched_barrier(0);
    if (INV) dit_regs<32, true>(x, W, B); else dif_regs<32, true>(x, W, B);
#pragma unroll
    for (int i = 0; i < 32; ++i) F.C[PH(512 * i + F.tid)] = x[i];
}
template <bool INV> __device__ __forceinline__ void pass2(const FftCtx& F_) {
    FftCtx F = F_; asm volatile("" : "+v"(F.tid)); const TwC W = make_twc();
    const int blk = F.tid >> 4, q = F.tid & 15;
    cf2 x[32], B[5];
#pragma unroll
    for (int s = 0; s < 5; ++s) B[s] = F.T14[q << (5 + s)];
#pragma unroll
    for (int i = 0; i < 32; ++i) x[i] = F.C[PH(512 * blk + q + 16 * i)];
    __builtin_amdgcn_sched_barrier(0);
    if (INV) dit_regs<32, true>(x, W, B); else dif_regs<32, true>(x, W, B);
#pragma unroll
    for (int i = 0; i < 32; ++i) F.C[PH(512 * blk + q + 16 * i)] = x[i];
}
template <int MODE> __device__ __forceinline__ void pass3(const FftCtx& F_, cf2* K) {
    FftCtx F = F_; asm volatile("" : "+v"(F.tid)); const TwC W = make_twc();
    cf2 B[5];
#pragma unroll
    for (int s = 0; s < 5; ++s) B[s] = mk2(1.f, 0.f);
#pragma unroll
    for (int g = 0; g < 2; ++g) {
        const int base = 16 * (F.tid + 512 * g); cf2 y[16];
#pragma unroll
        for (int i = 0; i < 16; ++i) y[i] = F.C[PH(base + i)];
        __builtin_amdgcn_sched_barrier(0);
        dif_regs<16, false>(y, W, B);
        if (MODE == 0) {
#pragma unroll
            for (int r = 0; r < 16; ++r) (K + (g * 16 + r) * 512)[F.tid] = y[r];
        } else {
#pragma unroll
            for (int r = 0; r < 16; ++r) { y[r] = cmul(y[r], (K + (g * 16 + r) * 512)[F.tid]); if ((r & 7) == 7) __builtin_amdgcn_sched_barrier(0); }
            dit_regs<16, false>(y, W, B);
#pragma unroll
            for (int i = 0; i < 16; ++i) F.C[PH(base + i)] = y[i];
        }
        __builtin_amdgcn_sched_barrier(0);
    }
}
__device__ __forceinline__ void fft_to_spectrum(const FftCtx& F, cf2* K) {
    pass1<false>(F); __syncthreads(); pass2<false>(F); __syncthreads(); pass3<0>(F, K); __syncthreads();
}
__device__ __forceinline__ void fft_conv(const FftCtx& F, cf2* K) {
    pass1<false>(F); __syncthreads(); pass2<false>(F); __syncthreads(); pass3<1>(F, K); __syncthreads(); pass2<true>(F); __syncthreads(); pass1<true>(F); __syncthreads();
}

#define LTID int tl = tid; asm volatile("" : "+v"(tl));
__device__ __forceinline__ void hyena_unit2(ArgsP a, int l, int ch, LAS unsigned char* lds, int tid, int wave, int lane, const int DRY) {
    LAS cf2* C = (LAS cf2*)lds;
    LAS float* red = (LAS float*)(lds + CPAD * 8); LAS float* wcol = red + 16;
    const cf2* T15 = (const cf2*)(a->ws + WS_TW15);
    FftCtx F; F.C = C; F.T14 = (const cf2*)(a->ws + WS_TW14); F.tid = tid;
    const float* H2T = (const float*)(a->ws + WS_H2);
    cf2* KE = (cf2*)(a->ws + WS_KF + (size_t)blockIdx.x * 262144); cf2* KO = KE + FN;
    float* UT = (float*)(a->ws + WS_UT);
    float* v0 = UT + ((size_t)(0 * 2 + 0) * 256 + ch) * SEQ; float* v1 = UT + ((size_t)(0 * 2 + 1) * 256 + ch) * SEQ;
    const float delta = fabsf(HY_MIN_DECAY + (float)ch * ((HY_MAX_DECAY - HY_MIN_DECAY) / 255.0f));
#pragma unroll 1
    for (int o = 0; o < 2; ++o) {
        const float* w3 = a->in[I_HYW3] + (size_t)l * 64 * 1024 + o * 512 + ch;
        __syncthreads();
        { LTID if (tl < 128) wcol[tl] = w3[(size_t)(tl & 63) * 1024 + (tl >> 6) * 256]; }
        __syncthreads();
        float asum = 0.f;
        {   LTID const LAS f32x4* wc4 = (const LAS f32x4*)wcol; asm volatile("" : "+v"(wc4));
#pragma unroll 1
            for (int i0 = 0; i0 < 32; i0 += 4) {
                const float* hc = H2T + tl + NTHREADS * i0;
                float f[4] = {0.f, 0.f, 0.f, 0.f}, bk[4] = {0.f, 0.f, 0.f, 0.f};
#pragma unroll
                for (int j4 = 0; j4 < 16; ++j4) {
                    const f32x4 wf = wc4[j4], wb = wc4[16 + j4];
#pragma unroll
                    for (int jj = 0; jj < 4; ++jj) {
#pragma unroll
                        for (int e = 0; e < 4; ++e) { const float hv = hc[(size_t)(4 * j4 + jj) * SEQ + NTHREADS * e]; f[e] += hv * wf[jj]; bk[e] += hv * wb[jj]; }
                    }
                }
#pragma unroll
                for (int e = 0; e < 4; ++e) {
                    const int t = tl + NTHREADS * (i0 + e);
                    const float dec = expf(-((float)t * (1.0f / (float)(SEQ - 1))) * delta);
                    const float fv = f[e] * dec, bv = bk[e] * dec; asum += fabsf(fv) + fabsf(bv);
                    C[PH(t)] = mk2(fv, bv);
                }
            }
        }
        const float tot = block_sum(asum, red, tid, wave, lane);
        const float scale = 1.0f / ((tot + EPSF) * (float)(2 * FN));
        { LTID
#pragma unroll 8
        for (int i = 0; i < 32; ++i) {
            const int t = tl + NTHREADS * i;
            const float fw = C[PH(t)].x, bw = (t > 0) ? C[PH(FN - t)].y : 0.f;
            const float d = (fw - bw) * scale; const cf2 w = T15[t];
            KE[t] = mk2((fw + bw) * scale, 0.f); KO[t] = mk2(d * w.x, d * w.y);
        } }
        __syncthreads();
        { LTID
#pragma unroll 16
        for (int i = 0; i < 32; ++i) { const int t = tl + NTHREADS * i; C[PH(t)] = KE[t]; } }
        __syncthreads();
        fft_to_spectrum(F, KE);
        { LTID
#pragma unroll 16
        for (int i = 0; i < 32; ++i) { const int t = tl + NTHREADS * i; C[PH(t)] = KO[t]; } }
        __syncthreads();
        fft_to_spectrum(F, KO);
        { LTID
#pragma unroll 16
        for (int i = 0; i < 32; ++i) { const int t = tl + NTHREADS * i; C[PH(t)] = mk2(v0[t], v1[t]); } }
        __syncthreads();
        fft_conv(F, KE);
        { LTID
#pragma unroll 16
        for (int i = 0; i < 32; ++i) { const int t = tl + NTHREADS * i; KE[t] = C[PH(t)]; } }
        __syncthreads();
        { LTID
#pragma unroll 8
        for (int i = 0; i < 32; ++i) { const int t = tl + NTHREADS * i; C[PH(t)] = cmul(mk2(v0[t], v1[t]), T15[t]); } }
        __syncthreads();
        fft_conv(F, KO);
        const float sk = a->in[I_HYSKIP][((size_t)l * 2 + o) * 256 + ch];
        const float* m0 = UT + ((size_t)((1 + o) * 2 + 0) * 256 + ch) * SEQ; const float* m1 = UT + ((size_t)((1 + o) * 2 + 1) * 256 + ch) * SEQ;
        { LTID
#pragma unroll 8
        for (int i = 0; i < 32; ++i) {
            const int t = tl + NTHREADS * i;
            const cf2 bq = cmulc(C[PH(t)], T15[t]); const cf2 av = KE[t];
            const float x0 = v0[t], x1 = v1[t];
            const float y0 = av.x + bq.x + sk * x0, y1 = av.y + bq.y + sk * x1;
            v0[t] = m0[t] * y0; v1[t] = m1[t] * y1;
        } }
        __syncthreads();
    }
}

__device__ __forceinline__ void hyena_ctx_unit(ArgsP a, int l, int ch, LAS unsigned char* lds, int tid, int wave, int lane) {
    LAS float* F = (LAS float*)lds;
    LAS float* U = F + 1024;
    LAS float* Z = U + 1536;
    LAS float* red = Z + 512;
    const float* H2C = (const float*)(a->ws + WS_H2C); bf16_t* Y = (bf16_t*)(a->ws + WS_XN);
    const float delta = fabsf(HY_MIN_DECAY + (float)ch * ((HY_MAX_DECAY - HY_MIN_DECAY) / 255.0f));
    __syncthreads();
    {
        const int o = tid >> 8, t = tid & 255; const float* w3 = a->in[I_HYW3] + (size_t)l * 64 * 1024 + o * 512 + ch; const float* hr = H2C + t * 64;
        float f = 0.f, bk = 0.f;
#pragma unroll 8
        for (int j = 0; j < 64; ++j) { const float hv = hr[j]; f += hv * w3[(size_t)j * 1024]; bk += hv * w3[(size_t)j * 1024 + 256]; }
        const float dec = expf(-((float)t * (1.0f / 255.0f)) * delta); f *= dec; bk *= dec;
        float s = wave_sum(fabsf(f) + fabsf(bk));
        if (lane == 0) red[wave] = s;
        __syncthreads();
        const float tot = (red[4 * o] + red[4 * o + 1]) + (red[4 * o + 2] + red[4 * o + 3]);
        const float sc = 1.f / (tot + EPSF);
        F[(o * 2 + 0) * 256 + t] = f * sc; F[(o * 2 + 1) * 256 + t] = bk * sc;
    }
    {
        const int b = tid >> 8, t = tid & 255; const float* UC = (const float*)(a->ws + WS_UC);
#pragma unroll
        for (int p = 0; p < 3; ++p) U[(p * 2 + b) * 256 + t] = UC[((size_t)(p * 2 + b) * 256 + ch) * 256 + t];
    }
    __syncthreads();
    const int b = tid >> 8, t = tid & 255;
    {
        const LAS float* fw = F, *bw = F + 256; const LAS float* x = U + b * 256; float y = 0.f;
        for (int s = 0; s <= t; ++s) y += fw[t - s] * x[s];
        for (int s = t + 1; s < CTXL; ++s) y += bw[s - t] * x[s];
        y += a->in[I_HYSKIP][((size_t)l * 2 + 0) * 256 + ch] * x[t];
        Z[b * 256 + t] = U[(2 + b) * 256 + t] * y;
    }
    __syncthreads();
    {
        const LAS float* fw = F + 512, *bw = F + 768; const LAS float* x = Z + b * 256; float y = 0.f;
        for (int s = 0; s <= t; ++s) y += fw[t - s] * x[s];
        for (int s = t + 1; s < CTXL; ++s) y += bw[s - t] * x[s];
        y += a->in[I_HYSKIP][((size_t)l * 2 + 1) * 256 + ch] * x[t];
        Y[((size_t)MLAT + b * CTXL + t) * DM + ch] = (bf16_t)f2bf(U[(4 + b) * 256 + t] * y);
    }
    __syncthreads();
}

#define MIX_TID int tid = threadIdx.x; asm volatile("" : "+v"(tid)); const int lane = tid & 63, wave = __builtin_amdgcn_readfirstlane(tid >> 6); (void)lane; (void)wave;
__device__ __forceinline__ void mix_phase(int l, LAS unsigned char* lds, char* lds_generic) {
    using attn_body::AttnJob; typedef attn_body::bf16 abf;
    const int G = gridDim.x, bx = blockIdx.x;
#ifndef NO_HY
    for (int u = bx; u < 256; u += G) { MIX_TID ArgsP a = args_ptr();
#ifdef PROBE_HY
#pragma unroll 1
        for (int rep = 1; rep >= 0; --rep)
#else
        const int rep = 0;
#endif
        hyena_unit2(a, l, u, lds, tid, wave, lane, rep); }
#endif
#ifndef NO_LRU
    for (int u = bx - 128; u >= 0 && u < 4; u += G) { MIX_TID ArgsP a = args_ptr(); lru_carry_unit(a, u, tid); }
#endif
#ifndef NO_ATT
    for (int v = bx; v < 512; v += G) {
        ArgsP a = args_ptr(); const abf* PB = (const abf*)(a->ws + WS_PB); abf* Y = (abf*)(a->ws + WS_XN);
        const int xcd = v & 7, ii = (v & 255) >> 3, rr = v >> 8, uu = 2 * ii + rr;
        const int b = xcd >> 2, kvh = (xcd >> 1) & 1, h = 2 * kvh + (uu & 1), qb = (uu >> 1) * 2 + (xcd & 1);
        AttnJob J; J.Q = PB + 768 + 64 * h; J.K = PB + 1024 + 64 * (h >> 1); J.V = PB + 1152 + 64 * (h >> 1); J.O = Y + 768 + 64 * h;
        J.qrow0 = b * SEQ + qb * 256; J.ctxrow0 = MLAT + b * CTXL; J.bandrow0 = b * SEQ; J.NT = 4 + SEQ / 64; J.qpos0 = qb * 256; J.kpos0 = 0; J.sink2 = 0.f; J.has_sink = 0;
        attn_body::attn_unit<8, false>(J, lds_generic);
#ifdef PROBE_ATT
        attn_body::attn_unit<8, false>(J, lds_generic);
#endif
    }
    for (int v = bx; v < 512; v += G) {
        ArgsP a = args_ptr(); const abf* PB = (const abf*)(a->ws + WS_PB); abf* Y = (abf*)(a->ws + WS_XN);
        const int qb = v & 63, h = (v >> 6) & 3, b = v >> 8;
        const int k0 = (qb == 0) ? 0 : qb * 256 - 128, k1 = (qb == 63) ? SEQ : qb * 256 + 384;
        AttnJob J; J.Q = PB + 256 + 64 * h; J.K = PB + 512 + 64 * (h >> 1); J.V = PB + 640 + 64 * (h >> 1); J.O = Y + 512 + 64 * h;
        J.qrow0 = b * SEQ + qb * 256; J.ctxrow0 = MLAT + b * CTXL; J.bandrow0 = b * SEQ + k0; J.NT = 4 + (k1 - k0) / 64; J.qpos0 = qb * 256; J.kpos0 = k0;
        J.sink2 = a->in[I_SINK][l * 4 + h] * LOG2E; J.has_sink = 1;
        attn_body::attn_unit<8, true>(J, lds_generic);
    }
    if (l + 1 < DEPTH)
    for (int v = bx - 64; v >= 0 && v < 16; v += G) {
        ArgsP a = args_ptr(); const abf* PB = (const abf*)(a->ws + WS_PB); abf* Y = (abf*)(a->ws + WS_XN);
        const int h = v & 3, b = (v >> 2) & 1, glb = v >> 3;
        AttnJob J; J.Q = PB + (glb ? 768 : 256) + 64 * h; J.K = PB + (glb ? 1024 : 512) + 64 * (h >> 1); J.V = PB + (glb ? 1152 : 640) + 64 * (h >> 1); J.O = Y + (glb ? 768 : 512) + 64 * h;
        J.qrow0 = MLAT + b * CTXL; J.ctxrow0 = MLAT + b * CTXL; J.bandrow0 = 0; J.NT = 4; J.qpos0 = 0; J.kpos0 = 0;
        J.sink2 = glb ? 0.f : a->in[I_SINK][l * 4 + h] * LOG2E; J.has_sink = glb ? 0 : 1;
        attn_body::attn_unit<8, false>(J, lds_generic);
    }
#endif
#ifndef NO_CHY
    if (l + 1 < DEPTH)
    for (int u = bx; u < 256; u += G) { MIX_TID ArgsP a = args_ptr(); hyena_ctx_unit(a, l, u, lds, tid, wave, lane); }
#endif
}

#ifdef NO_GEMM
#define GEMM_CALL if (0)
#else
#define GEMM_CALL
#endif
#define LAUNDER_TID int tid = threadIdx.x; asm volatile("" : "+v"(tid)); const int lane = tid & 63, wave = __builtin_amdgcn_readfirstlane(tid >> 6); (void)lane; (void)wave;
template <int l> __device__ __forceinline__ void layer_body(const XcdBarrier& bar, LAS unsigned char* lds, char* lds_generic) {

        {   ArgsP a = args_ptr(); unsigned char* ws = a->ws; bf16_t* XN = (bf16_t*)(ws + WS_XN); bf16_t* Hb = (bf16_t*)(ws + WS_H); float* XC = (float*)(ws + WS_XC); const float* MOD = (const float*)(ws + WS_MOD) + (size_t)l * 3 * NMODV; (void)XN; (void)Hb; (void)XC; (void)MOD;
            pg8::Gemm g{XN, (const bf16_t*)(ws + WS_W13A), MTOT, 2 * DFF, DM, DM, (2 * DFF) / 256}; pg8::StaticOrder S; S.init(MTOT, 2 * DFF, gridDim.x, blockIdx.x);
            EpiSwiGLU E{Hb}; GEMM_CALL pg8::gemm_phase<EpiSwiGLU, pg8::StaticOrder, true, true>(lds, g, S, E);
        }
        xcd_barrier(bar);
        {   ArgsP a = args_ptr(); unsigned char* ws = a->ws; bf16_t* XN = (bf16_t*)(ws + WS_XN); bf16_t* Hb = (bf16_t*)(ws + WS_H); float* XC = (float*)(ws + WS_XC); const float* MOD = (const float*)(ws + WS_MOD) + (size_t)l * 3 * NMODV; (void)XN; (void)Hb; (void)XC; (void)MOD;
            pg8::Gemm g{Hb, (const bf16_t*)(ws + WS_W2A), MLAT, DM, DFF, DFF, (DM) / 256}; pg8::StaticOrder S; S.init(MLAT, DM, gridDim.x, blockIdx.x);
            EpiResid E{a->out, XC, MOD + 2 * DM, 0.5f, (l == 0) ? a->in[I_X] : (const float*)a->out}; GEMM_CALL pg8::gemm_phase<EpiResid, pg8::StaticOrder, true, true>(lds, g, S, E);
            { pg8::Gemm gc{Hb + (size_t)MLAT * DFF, (const bf16_t*)(ws + WS_W2A), NBATCH * CTXL, DM, DFF, DFF / 11, DM / 256}; pg8::StaticOrder Sc; Sc.init(NBATCH * CTXL, DM * 11, gridDim.x, blockIdx.x);
              EpiResidCtxSplitK Ec{(float*)(ws + WS_PART), MOD + 2 * DM, 0.5f, DM / 256}; GEMM_CALL pg8::gemm_phase<EpiResidCtxSplitK, pg8::StaticOrder, true, true>(lds, gc, Sc, Ec); }
        }
        xcd_barrier(bar);
        { LAUNDER_TID ArgsP a = args_ptr(); norm_phase(a, l, 1, wave, lane, 11); }
        xcd_barrier(bar);
        {   ArgsP a = args_ptr(); unsigned char* ws = a->ws; bf16_t* XN = (bf16_t*)(ws + WS_XN); bf16_t* Hb = (bf16_t*)(ws + WS_H); float* XC = (float*)(ws + WS_XC); const float* MOD = (const float*)(ws + WS_MOD) + (size_t)l * 3 * NMODV; (void)XN; (void)Hb; (void)XC; (void)MOD;
            pg8::Gemm g{XN, (const bf16_t*)(ws + WS_WIN), MTOT, DIN, DM, DM, (DIN) / 256}; pg8::StaticOrder S; S.init(MTOT, DIN, gridDim.x, blockIdx.x);
            EpiProj E{(bf16_t*)(ws + WS_PA), (bf16_t*)(ws + WS_PB)}; GEMM_CALL pg8::gemm_phase<EpiProj, pg8::StaticOrder, true, true>(lds, g, S, E);
        }
        xcd_barrier(bar);
#ifndef NO_E1
        { LAUNDER_TID ArgsP a = args_ptr(); e1_phase(a, l, lds, tid, wave, lane); }
#endif
        xcd_barrier(bar);
        {   ArgsP a = args_ptr(); unsigned char* ws = a->ws; bf16_t* XN = (bf16_t*)(ws + WS_XN); bf16_t* Hb = (bf16_t*)(ws + WS_H); float* XC = (float*)(ws + WS_XC); const float* MOD = (const float*)(ws + WS_MOD) + (size_t)l * 3 * NMODV; (void)XN; (void)Hb; (void)XC; (void)MOD;
            pg8::Gemm g{(const bf16_t*)(ws + WS_R), (const bf16_t*)(ws + WS_WLRU), MTOT, 1024, 256, 256, (1024) / 256}; pg8::StaticOrder S; S.init(MTOT, 1024, gridDim.x, blockIdx.x);
            EpiLru E{(unsigned*)(ws + WS_RAW0), (unsigned*)(ws + WS_RAW1)};
            GEMM_CALL pg8::gemm_phase<EpiLru, pg8::StaticOrder, true, true>(lds, g, S, E);
        }
        xcd_barrier(bar);
        { LAUNDER_TID ArgsP a = args_ptr(); lru_gate_phase(a, l, tid); }
        xcd_barrier(bar);
        mix_phase(l, lds, lds_generic);
        xcd_barrier(bar);
        { LAUNDER_TID ArgsP a = args_ptr(); e2_phase(a, lds, tid, wave, lane); }
        xcd_barrier(bar);
        {   ArgsP a = args_ptr(); unsigned char* ws = a->ws; bf16_t* XN = (bf16_t*)(ws + WS_XN); bf16_t* Hb = (bf16_t*)(ws + WS_H); float* XC = (float*)(ws + WS_XC); const float* MOD = (const float*)(ws + WS_MOD) + (size_t)l * 3 * NMODV; (void)XN; (void)Hb; (void)XC; (void)MOD;
            pg8::Gemm g{XN, (const bf16_t*)(ws + WS_WOUT), MLAT, DM, DM, DM, (DM) / 256}; pg8::StaticOrder S; S.init(MLAT, DM, gridDim.x, blockIdx.x);
            EpiResid E{a->out, XC, MOD + 5 * DM, 1.0f, a->out}; GEMM_CALL pg8::gemm_phase<EpiResid, pg8::StaticOrder, true, true>(lds, g, S, E);
            if (l + 1 < DEPTH) { pg8::Gemm gc{XN + (size_t)MLAT * DM, (const bf16_t*)(ws + WS_WOUT), NBATCH * CTXL, DM, DM, DM / 4, DM / 256}; pg8::StaticOrder Sc; Sc.init(NBATCH * CTXL, DM * 4, gridDim.x, blockIdx.x);
              EpiResidCtxSplitK Ec{(float*)(ws + WS_PART), MOD + 5 * DM, 1.0f, DM / 256}; GEMM_CALL pg8::gemm_phase<EpiResidCtxSplitK, pg8::StaticOrder, true, true>(lds, gc, Sc, Ec); }
        }
        xcd_barrier(bar);
        { LAUNDER_TID ArgsP a = args_ptr(); norm_phase(a, l, 2, wave, lane, (l + 1 < DEPTH) ? 4 : 0); }
        xcd_barrier(bar);
        {   ArgsP a = args_ptr(); unsigned char* ws = a->ws; bf16_t* XN = (bf16_t*)(ws + WS_XN); bf16_t* Hb = (bf16_t*)(ws + WS_H); float* XC = (float*)(ws + WS_XC); const float* MOD = (const float*)(ws + WS_MOD) + (size_t)l * 3 * NMODV; (void)XN; (void)Hb; (void)XC; (void)MOD;
            constexpr int M5 = (l + 1 < DEPTH) ? MTOT : MLAT;
            pg8::Gemm g{XN, (const bf16_t*)(ws + WS_W13B), M5, 2 * DFF, DM, DM, (2 * DFF) / 256}; pg8::StaticOrder S; S.init(M5, 2 * DFF, gridDim.x, blockIdx.x);
            EpiSwiGLU E{Hb}; GEMM_CALL pg8::gemm_phase<EpiSwiGLU, pg8::StaticOrder, true, true>(lds, g, S, E);
        }
        xcd_barrier(bar);
        {   ArgsP a = args_ptr(); unsigned char* ws = a->ws; bf16_t* XN = (bf16_t*)(ws + WS_XN); bf16_t* Hb = (bf16_t*)(ws + WS_H); float* XC = (float*)(ws + WS_XC); const float* MOD = (const float*)(ws + WS_MOD) + (size_t)l * 3 * NMODV; (void)XN; (void)Hb; (void)XC; (void)MOD;
            pg8::Gemm g{Hb, (const bf16_t*)(ws + WS_W2B), MLAT, DM, DFF, DFF, (DM) / 256}; pg8::StaticOrder S; S.init(MLAT, DM, gridDim.x, blockIdx.x);
            EpiResid E{a->out, XC, MOD + 8 * DM, 0.5f, a->out}; GEMM_CALL pg8::gemm_phase<EpiResid, pg8::StaticOrder, true, true>(lds, g, S, E);
            if (l + 1 < DEPTH) { pg8::Gemm gc{Hb + (size_t)MLAT * DFF, (const bf16_t*)(ws + WS_W2B), NBATCH * CTXL, DM, DFF, DFF / 11, DM / 256}; pg8::StaticOrder Sc; Sc.init(NBATCH * CTXL, DM * 11, gridDim.x, blockIdx.x);
              EpiResidCtxSplitK Ec{(float*)(ws + WS_PART), MOD + 8 * DM, 0.5f, DM / 256}; GEMM_CALL pg8::gemm_phase<EpiResidCtxSplitK, pg8::StaticOrder, true, true>(lds, gc, Sc, Ec); }
        }
        xcd_barrier(bar);
        if (l + 1 < DEPTH) { LAUNDER_TID ArgsP a = args_ptr(); prep_layer(a, l + 1, lds, tid, wave, lane); norm_phase(a, l + 1, 0, wave, lane, 11); xcd_barrier(bar); }
    }

__global__ void __launch_bounds__(NTHREADS, 2) fwd_megakernel(Args a_byvalue) {
    extern __shared__ __attribute__((aligned(16))) unsigned char lds_raw[];
    cg::grid_group grid = cg::this_grid();
    LAS unsigned char* lds = (LAS unsigned char*)lds_raw;
    volatile LAS unsigned* bst = (volatile LAS unsigned*)(lds + LDS_BYTES - 64);
    if (threadIdx.x < 16) bst[threadIdx.x] = 0u;
    __syncthreads();
    XcdBarrier bar = xcd_barrier_post((unsigned*)args_ptr()->ws, bst);

    { LAUNDER_TID ArgsP a = args_ptr();
#ifndef NO_PRO
    prologue_phase(a, lds, tid, wave, lane);
    prep_layer(a, 0, lds, tid, wave, lane);
#endif
    grid.sync();
    norm_phase(a, 0, 0, wave, lane, 0, true); }
    xcd_barrier(bar);
    layer_body<0>(bar, lds, (char*)lds_raw);
    layer_body<1>(bar, lds, (char*)lds_raw);
    layer_body<2>(bar, lds, (char*)lds_raw);
    layer_body<3>(bar, lds, (char*)lds_raw);
    { LAUNDER_TID ArgsP a = args_ptr(); final_norm_phase(a, wave, lane); }
}

extern "C" void kernel_launch(void* const* d_in, const int* in_sizes, int n_in, void* d_out, int out_size, void* d_ws, size_t ws_size, hipStream_t stream) {
    static int grid_blocks = 0;
    if (grid_blocks == 0) {
        if (n_in != 32 || out_size != MLAT * DM || ws_size < WS_END) { fprintf(stderr, "kernel_launch: unexpected problem: n_in %d out %d ws %zu (need %zu)\n", n_in, out_size, ws_size, (size_t)WS_END); grid_blocks = -1; return; }
        int dev = 0, cus = 0, per_cu = 0;
        hipGetDevice(&dev); hipDeviceGetAttribute(&cus, hipDeviceAttributeMultiprocessorCount, dev);
        hipFuncSetAttribute((const void*)fwd_megakernel, hipFuncAttributeMaxDynamicSharedMemorySize, LDS_BYTES);
        hipOccupancyMaxActiveBlocksPerMultiprocessor(&per_cu, (const void*)fwd_megakernel, NTHREADS, LDS_BYTES);
        if (per_cu < 1) { fprintf(stderr, "kernel_launch: occupancy query says %d blocks per CU\n", per_cu); per_cu = 1; }
        (void)hipGetLastError();
        grid_blocks = cus * per_cu;
    }
    if (grid_blocks < 0) return;
    Args a{};
    for (int i = 0; i < 32; ++i) a.in[i] = (const float*)d_in[i];
    a.out = (float*)d_out; a.ws = (unsigned char*)d_ws;
    (void)hipMemsetAsync(d_ws, 0, 16384, stream);
    void* args[] = {&a};
    hipError_t e = hipLaunchCooperativeKernel((const void*)fwd_megakernel, dim3(grid_blocks), dim3(NTHREADS), args, LDS_BYTES, stream);
    if (e != hipSuccess) fprintf(stderr, "cooperative launch failed: %s (grid %d)\n", hipGetErrorString(e), grid_blocks);
}
```

```cpp
#include <hip/hip_runtime.h>
#include <hip/hip_cooperative_groups.h>
#include <hip/hip_bf16.h>
#include <cstdio>
#include <cstdint>
#include <cmath>
namespace cg = cooperative_groups;
namespace pg8 {
#define PG8_LAS __attribute__((address_space(3)))
typedef unsigned short bf16_t;
typedef short bf16x8 __attribute__((ext_vector_type(8)));
typedef float f32x4 __attribute__((ext_vector_type(4)));
typedef unsigned u32x4 __attribute__((ext_vector_type(4)));
constexpr int BM = 256, BK = 64, HALF = 128, HTB = HALF * BK * 2  , STAGE_BYTES = 8 * HTB, NXCD = 8, WGM = 8;

__host__ __device__ __forceinline__ int lds_byte(int r, int c) { const int st = (r >> 4) * 2 + (c >> 5), rr = r & 15, cc = c & 31, ob = rr * 64 + cc * 2; return st * 1024 + (ob ^ (((ob >> 9) & 1) << 5)); }
__host__ __device__ __forceinline__ void stage_rc(int b, int& R, int& C) { const int st = b / 1024, sb = b % 1024, swz = sb ^ (((sb >> 9) & 1) << 5); R = (st >> 1) * 16 + swz / 64; C = (st & 1) * 32 + (swz % 64) / 2; }
__host__ __device__ __forceinline__ int perm32(int rho) { const int n = rho >> 4, i = rho & 15; return 8 * (i >> 2) + 4 * n + (i & 3); }

struct Unit { int pm, pn; };
struct Gemm { const bf16_t* A; const bf16_t* Bt; int M, N, K; int KL, nNr; };

struct StaticOrder {
    int nM, nN, nwg, G, c;
    __host__ __device__ void init(int M, int N, int G_, int c_) { nM = M / BM; nN = N / BM; nwg = nM * nN; G = G_; c = c_; }
    __host__ __device__ bool next(int i, Unit& u) const {
        const long L = (long)i * G + c; if (L >= nwg) return false;
        int wgid = (int)L; { const int q = nwg / NXCD, r = nwg % NXCD, xcd = wgid % NXCD, off = wgid / NXCD; wgid = (xcd < r ? xcd * (q + 1) : r * (q + 1) + (xcd - r) * q) + off; }
        const int nig = WGM * nN, gid = wgid / nig, fm = gid * WGM, gsz = (nM - fm) < WGM ? (nM - fm) : WGM;
        u.pm = fm + ((wgid % nig) % gsz); u.pn = (wgid % nig) / gsz; return true;
    }
    __device__ __forceinline__ void a_ready(const Unit&) const {}
    __device__ __forceinline__ void done(const Unit&) const {}
};

__device__ __forceinline__ unsigned cvt_pk_bf16(float lo, float hi) { unsigned r; asm volatile("v_cvt_pk_bf16_f32 %0, %1, %2" : "=v"(r) : "v"(lo), "v"(hi)); return r; }
typedef float f32x2 __attribute__((ext_vector_type(2)));
template <class Epi, class Sched, bool ALIGN_EPI = false, bool SP2 = false>
__device__ __forceinline__ void gemm_phase(PG8_LAS unsigned char* lds, const Gemm g, const Sched& S, const Epi& E) {
    int tid_ = threadIdx.x; asm volatile("" : "+v"(tid_));
    const int tid = tid_, wid = __builtin_amdgcn_readfirstlane(tid >> 6), lane = tid & 63, wr = wid >> 2, wc = wid & 3, fr = lane & 15, fq = lane >> 4;
    const int K = g.K, nt = g.KL / BK;
    unsigned voffA[2], voffB[2];
#pragma unroll
    for (int i = 0; i < 2; ++i) { int R, C; stage_rc(tid * 16 + i * 8192, R, C); const int Rb = Epi::PERM ? ((R & ~31) + perm32(R & 31)) : R;
        voffA[i] = (unsigned)(R * K + C) * 2u; voffB[i] = (unsigned)(Rb * K + C) * 2u; }
    const size_t kstep = (size_t)(BK * 2);
    const size_t hstep = (size_t)HALF * K * 2;
    const size_t tstep = 2 * hstep;
    const unsigned ldsw = (unsigned)wid * 1024u;
    const int aoff = lds_byte(wr * 64 + fr, fq * 8), boff = lds_byte(wc * 32 + fr, fq * 8);
#define PG8_SA(b, h) (((b) * 2 + (h)) * HTB)
#define PG8_SB(b, h) ((4 + (b) * 2 + (h)) * HTB)
#define PG8_STAGE(bufoff, gbase, voff) do { _Pragma("unroll") for (int _i = 0; _i < 2; ++_i) \
        __builtin_amdgcn_global_load_lds((const unsigned*)((const char*)(gbase) + (voff)[_i]), (PG8_LAS unsigned*)(lds + (bufoff) + ldsw + _i * 8192), 16, 0, 0); } while (0)
#define PG8_LDA(dst, b, h) do { _Pragma("unroll") for (int m = 0; m < 4; ++m) _Pragma("unroll") for (int k = 0; k < 2; ++k) dst[m][k] = *(const PG8_LAS bf16x8*)(lds + PG8_SA(b, h) + aoff + m * 2048 + k * 1024); } while (0)
#define PG8_LDB(dst, b, h) do { _Pragma("unroll") for (int n = 0; n < 2; ++n) _Pragma("unroll") for (int k = 0; k < 2; ++k) dst[n][k] = *(const PG8_LAS bf16x8*)(lds + PG8_SB(b, h) + boff + n * 2048 + k * 1024); } while (0)
#define PG8_MMA(ai, bj, At, Bt) do { __builtin_amdgcn_s_setprio(1); _Pragma("unroll") for (int m = 0; m < 4; ++m) _Pragma("unroll") for (int n = 0; n < 2; ++n) _Pragma("unroll") for (int k = 0; k < 2; ++k) \
        acc[ai][bj][m][n] = __builtin_amdgcn_mfma_f32_16x16x32_bf16(Bt[n][k], At[m][k], acc[ai][bj][m][n], 0, 0, 0); __builtin_amdgcn_s_setprio(0); } while (0)
#define PG8_WAIT_V(n) asm volatile("s_waitcnt vmcnt(" #n ")" ::: "memory")
#define PG8_WAIT_L(n) asm volatile("s_waitcnt lgkmcnt(" #n ")" ::: "memory")
#define PG8_BAR __builtin_amdgcn_s_barrier()
#define PG8_SCHED __builtin_amdgcn_sched_barrier(0)
    Unit cur, nxt; int ui = 0;
    if (!S.next(0, cur)) return;
    f32x4 acc[2][2][4][2];
#pragma unroll
    for (int a = 0; a < 2; ++a)
#pragma unroll
        for (int b = 0; b < 2; ++b)
#pragma unroll
            for (int m = 0; m < 4; ++m)
#pragma unroll
                for (int n = 0; n < 2; ++n) acc[a][b][m][n] = (f32x4){0.f, 0.f, 0.f, 0.f};
    bf16x8 At[4][2], B0[2][2], B1[2][2];
#define PG8_PA(u) ((const char*)g.A + (size_t)(u).pm * tstep + (size_t)((u).pn / g.nNr) * (size_t)g.KL * 2)
#define PG8_PB(u) ((const char*)g.Bt + (size_t)((u).pn % g.nNr) * tstep + (size_t)((u).pn / g.nNr) * (size_t)g.KL * 2)
    const char* cA = PG8_PA(cur); const char* cB = PG8_PB(cur);
    S.a_ready(cur);
    if constexpr (SP2) {
        PG8_STAGE(PG8_SB(0, 0), cB, voffB); PG8_STAGE(PG8_SB(0, 1), cB + hstep, voffB); PG8_STAGE(PG8_SA(0, 0), cA, voffA); PG8_STAGE(PG8_SA(0, 1), cA + hstep, voffA);
        if (wr == 1) PG8_BAR;
        PG8_WAIT_V(2); PG8_BAR;
        PG8_STAGE(PG8_SB(1, 0), cB + kstep, voffB); PG8_STAGE(PG8_SA(1, 0), cA + kstep, voffA); PG8_STAGE(PG8_SB(1, 1), cB + hstep + kstep, voffB);
        PG8_WAIT_V(6); PG8_BAR;
    } else {
        PG8_STAGE(PG8_SB(0, 0), cB, voffB); PG8_STAGE(PG8_SA(0, 0), cA, voffA); PG8_STAGE(PG8_SB(0, 1), cB + hstep, voffB); PG8_STAGE(PG8_SA(0, 1), cA + hstep, voffA);
        if (wr == 1) PG8_BAR;
        PG8_WAIT_V(4); PG8_BAR;
        PG8_STAGE(PG8_SB(1, 0), cB + kstep, voffB); PG8_STAGE(PG8_SA(1, 0), cA + kstep, voffA); PG8_STAGE(PG8_SB(1, 1), cB + hstep + kstep, voffB);
        PG8_WAIT_V(6); PG8_BAR;
    }
    for (;;) {
        const bool has_next = S.next(ui + 1, nxt);
        const char* nA = has_next ? PG8_PA(nxt) : cA; const char* nB = has_next ? PG8_PB(nxt) : cB;
        for (int t = 0; t < nt; t += 2) {
            const bool last = (t == nt - 2);
            const char* a1 = cA + (size_t)(t + 1) * kstep;
            const char* a2 = last ? nA : cA + (size_t)(t + 2) * kstep; const char* b2 = last ? nB : cB + (size_t)(t + 2) * kstep;
            const char* a3 = a2 + kstep; const char* b3 = b2 + kstep;
            if (last && has_next) S.a_ready(nxt);
            if constexpr (SP2) {
            PG8_LDB(B0, 0, 0); PG8_LDB(B1, 0, 1); PG8_SCHED; PG8_LDA(At, 0, 0); PG8_STAGE(PG8_SA(1, 1), a1 + hstep, voffA);
            PG8_WAIT_V(8); PG8_WAIT_L(0); PG8_BAR; PG8_MMA(0, 0, At, B0); PG8_MMA(0, 1, At, B1); PG8_BAR; PG8_SCHED;
            PG8_LDA(At, 0, 1); PG8_STAGE(PG8_SB(0, 0), b2, voffB); PG8_STAGE(PG8_SB(0, 1), b2 + hstep, voffB); PG8_STAGE(PG8_SA(0, 0), a2, voffA);
            PG8_WAIT_V(8); PG8_WAIT_L(0); PG8_BAR; PG8_MMA(1, 0, At, B0); PG8_MMA(1, 1, At, B1); PG8_BAR; PG8_SCHED;
            PG8_LDB(B0, 1, 0); PG8_LDB(B1, 1, 1); PG8_SCHED; PG8_LDA(At, 1, 0); PG8_STAGE(PG8_SA(0, 1), a2 + hstep, voffA);
            PG8_WAIT_V(8); PG8_WAIT_L(0); PG8_BAR; PG8_MMA(0, 0, At, B0); PG8_MMA(0, 1, At, B1); PG8_BAR; PG8_SCHED;
            PG8_LDA(At, 1, 1); PG8_STAGE(PG8_SB(1, 0), b3, voffB); PG8_STAGE(PG8_SB(1, 1), b3 + hstep, voffB); PG8_STAGE(PG8_SA(1, 0), a3, voffA);
            PG8_WAIT_V(8); PG8_WAIT_L(0); PG8_BAR; PG8_MMA(1, 0, At, B0); PG8_MMA(1, 1, At, B1); PG8_BAR; PG8_SCHED;
            } else {
            PG8_LDB(B0, 0, 0); PG8_SCHED; PG8_LDA(At, 0, 0); PG8_STAGE(PG8_SA(1, 1), a1 + hstep, voffA);
            PG8_WAIT_L(8); PG8_BAR; PG8_WAIT_L(0); PG8_MMA(0, 0, At, B0); PG8_BAR; PG8_SCHED;
            PG8_LDB(B1, 0, 1); PG8_STAGE(PG8_SB(0, 0), b2, voffB);
            PG8_BAR; PG8_WAIT_L(0); PG8_MMA(0, 1, At, B1); PG8_BAR;
            PG8_LDA(At, 0, 1); PG8_STAGE(PG8_SA(0, 0), a2, voffA);
            PG8_BAR; PG8_WAIT_L(0); PG8_MMA(1, 0, At, B0); PG8_BAR; PG8_SCHED;
            PG8_STAGE(PG8_SB(0, 1), b2 + hstep, voffB);
            PG8_WAIT_V(6); PG8_BAR; PG8_MMA(1, 1, At, B1); PG8_BAR;
            PG8_LDB(B0, 1, 0); PG8_SCHED; PG8_LDA(At, 1, 0); PG8_STAGE(PG8_SA(0, 1), a2 + hstep, voffA);
            PG8_WAIT_L(8); PG8_BAR; PG8_WAIT_L(0); PG8_MMA(0, 0, At, B0); PG8_BAR; PG8_SCHED;
            PG8_LDB(B1, 1, 1); PG8_STAGE(PG8_SB(1, 0), b3, voffB);
            PG8_BAR; PG8_WAIT_L(0); PG8_MMA(0, 1, At, B1); PG8_BAR;
            PG8_LDA(At, 1, 1); PG8_STAGE(PG8_SA(1, 0), a3, voffA);
            PG8_BAR; PG8_WAIT_L(0); PG8_MMA(1, 0, At, B0); PG8_BAR; PG8_SCHED;
            PG8_STAGE(PG8_SB(1, 1), b3 + hstep, voffB);
            PG8_WAIT_V(6); PG8_BAR; PG8_MMA(1, 1, At, B1); PG8_BAR;
            }
        }
        if constexpr (ALIGN_EPI) { if (wr == 0) PG8_BAR; }
        if constexpr (!Epi::AFTER_DRAIN) { E(acc, cur, wr, wc, fr, fq); S.done(cur); }
        if (!has_next) break;
#pragma unroll
        for (int a = 0; a < 2; ++a)
#pragma unroll
            for (int b = 0; b < 2; ++b)
#pragma unroll
                for (int m = 0; m < 4; ++m)
#pragma unroll
                    for (int n = 0; n < 2; ++n) acc[a][b][m][n] = (f32x4){0.f, 0.f, 0.f, 0.f};
        cur = nxt; cA = nA; cB = nB; ++ui;
        if constexpr (ALIGN_EPI) { if (wr == 1) PG8_BAR; }
    }
    PG8_WAIT_V(0);
    if constexpr (!ALIGN_EPI) { if (wr == 0) PG8_BAR; }
    PG8_BAR;
    if constexpr (Epi::AFTER_DRAIN) { E.fused(acc, cur, wr, wc, fr, fq, lds, wid, lane); S.done(cur); }
#undef PG8_SA
#undef PG8_SB
#undef PG8_STAGE
#undef PG8_LDA
#undef PG8_LDB
#undef PG8_MMA
#undef PG8_WAIT_V
#undef PG8_WAIT_L
#undef PG8_BAR
#undef PG8_SCHED
}
}
namespace attn_body {
using bf16=__hip_bfloat16;
using bf16x8=__attribute__((ext_vector_type(8)))short;
using s16x4=__attribute__((ext_vector_type(4)))short;
using f32x16=__attribute__((ext_vector_type(16)))float;
using u32x4=__attribute__((ext_vector_type(4)))unsigned;
constexpr int D=64,QP=1280,OP=1024;
constexpr int NW=8,QBLK=32,QB=QBLK*NW,KVBLK=64;
__device__ __forceinline__ int crow(int r,int hi){return (r&3)+8*(r>>2)+4*hi;}
#define SBAR() __builtin_amdgcn_sched_barrier(0)
__device__ __forceinline__ void wmask(f32x16&p0,f32x16&p1,int kb,int qpos){
  const float NEG=-INFINITY;
  #pragma unroll
  for(int r=0;r<16;++r){int dv=kb+(r&3)+8*(r>>2)-qpos; if(dv>128||dv<-128)p0[r]=NEG; if(dv+32>128||dv+32<-128)p1[r]=NEG;}
}

constexpr int NSLOT=3, SLOTB=8192;
constexpr int LDS_K=0, LDS_V=NSLOT*SLOTB, LDS_WS=2*NSLOT*SLOTB, LDS_OST=LDS_WS+NW*64*4, LDS_BYTES=LDS_OST+NW*4096;
constexpr float C2=0.125f*1.4426950408889634f;
__device__ __forceinline__ void glds16(const void*gsrc,unsigned lds_dst){unsigned keep;
  asm volatile("s_mov_b32 %0, m0\n\ts_mov_b32 m0, %2\n\ts_nop 0\n\tglobal_load_lds_dwordx4 %1, off\n\ts_mov_b32 m0, %0":"=&s"(keep):"v"(gsrc),"s"(lds_dst):"memory");}
__device__ __forceinline__ float max3f(float a,float b,float c){float r;asm("v_max3_f32 %0, %1, %2, %3":"=v"(r):"v"(a),"v"(b),"v"(c));return r;}
__device__ __forceinline__ float max2f(float a,float b){float r;asm("v_max_f32_e32 %0, %1, %2":"=v"(r):"v"(a),"v"(b));return r;}
__device__ __forceinline__ float fadd_s(float a,float b){float r;asm("v_add_f32_e32 %0, %1, %2":"=v"(r):"v"(a),"v"(b));return r;}
__device__ __forceinline__ float fsub_s(float a,float b){float r;asm("v_sub_f32_e32 %0, %1, %2":"=v"(r):"v"(a),"v"(b));return r;}
typedef float f32x2_t __attribute__((ext_vector_type(2))); typedef __bf16 bf16x2_t __attribute__((ext_vector_type(2)));
__device__ __forceinline__ unsigned cvtpk_s(float lo,float hi){f32x2_t v={lo,hi};bf16x2_t b=__builtin_convertvector(v,bf16x2_t);return __builtin_bit_cast(unsigned,b);}
#define WAIT_BAR(N) asm volatile("s_waitcnt vmcnt(" #N ") lgkmcnt(0)\n\ts_barrier":::"memory")

__device__ __forceinline__ void qkt(f32x16&p0,f32x16&p1,const char*Kslot,const bf16x8*qr,const f32x16&negm,int r32,int hi){
  const char*kb=Kslot+hi*1024+r32*16;
  #pragma unroll
  for(int d0=0;d0<4;++d0){
    const bf16x8 b0=*reinterpret_cast<const bf16x8*>(kb+d0*2048);
    const bf16x8 b1=*reinterpret_cast<const bf16x8*>(kb+d0*2048+512);
    if(d0==0){p0=__builtin_amdgcn_mfma_f32_32x32x16_bf16(b0,qr[0],negm,0,0,0);p1=__builtin_amdgcn_mfma_f32_32x32x16_bf16(b1,qr[0],negm,0,0,0);}
    else{p0=__builtin_amdgcn_mfma_f32_32x32x16_bf16(b0,qr[d0],p0,0,0,0);p1=__builtin_amdgcn_mfma_f32_32x32x16_bf16(b1,qr[d0],p1,0,0,0);}}
}
typedef __attribute__((address_space(3))) const char* lds_cptr;
typedef short v4i16_t __attribute__((ext_vector_type(4)));
__device__ __forceinline__ void kload8(bf16x8*kf,lds_cptr kp){
  kf[0]=*(const __attribute__((address_space(3))) bf16x8*)(kp);      kf[1]=*(const __attribute__((address_space(3))) bf16x8*)(kp+512);
  kf[2]=*(const __attribute__((address_space(3))) bf16x8*)(kp+2048); kf[3]=*(const __attribute__((address_space(3))) bf16x8*)(kp+2560);
  kf[4]=*(const __attribute__((address_space(3))) bf16x8*)(kp+4096); kf[5]=*(const __attribute__((address_space(3))) bf16x8*)(kp+4608);
  kf[6]=*(const __attribute__((address_space(3))) bf16x8*)(kp+6144); kf[7]=*(const __attribute__((address_space(3))) bf16x8*)(kp+6656);
}
__device__ __forceinline__ void kload2(bf16x8*kf,lds_cptr kp,int j){ kf[2*j]=*(const __attribute__((address_space(3))) bf16x8*)(kp+j*2048); kf[2*j+1]=*(const __attribute__((address_space(3))) bf16x8*)(kp+j*2048+512); }
__device__ __forceinline__ s16x4 vtr(lds_cptr p){ return __builtin_bit_cast(s16x4,__builtin_amdgcn_ds_read_tr16_b64_v4i16((__attribute__((address_space(3))) v4i16_t*)p)); }
__device__ __forceinline__ float rowmax(const f32x16&p0,const f32x16&p1){
  float a=max3f(p0[0],p0[1],p1[0]),b=max3f(p0[2],p0[3],p1[1]);a=max3f(a,p1[2],p1[3]);
  #pragma unroll
  for(int r=4;r<16;r+=4){a=max3f(a,p0[r],p0[r+1]);b=max3f(b,p0[r+2],p0[r+3]);a=max3f(a,p1[r],p1[r+1]);b=max3f(b,p1[r+2],p1[r+3]);}
  const float m=max2f(a,b);
  auto rr=__builtin_amdgcn_permlane32_swap(__float_as_uint(m),__float_as_uint(m),false,false);
  return max2f(__uint_as_float(rr[0]),__uint_as_float(rr[1]));
}
__device__ __forceinline__ void pv(f32x16*o,int vb,bf16x8 pa0,bf16x8 pa1,bf16x8 pa2,bf16x8 pa3){
  #pragma unroll
  for(int d0=0;d0<2;++d0){s16x4 lo[4],hi[4];
    #pragma unroll
    for(int ks=0;ks<4;++ks){
      asm volatile("ds_read_b64_tr_b16 %0,%1 offset:%c2":"=&v"(lo[ks]):"v"(vb),"i"(d0*4096+ks*1024):"memory");
      asm volatile("ds_read_b64_tr_b16 %0,%1 offset:%c2":"=&v"(hi[ks]):"v"(vb),"i"(d0*4096+ks*1024+512):"memory");}
    asm volatile("s_waitcnt lgkmcnt(0)":::"memory");SBAR();
    #define PK(k) (bf16x8){lo[k][0],lo[k][1],lo[k][2],lo[k][3],hi[k][0],hi[k][1],hi[k][2],hi[k][3]}
    o[d0]=__builtin_amdgcn_mfma_f32_32x32x16_bf16(pa0,PK(0),o[d0],0,0,0);
    o[d0]=__builtin_amdgcn_mfma_f32_32x32x16_bf16(pa1,PK(1),o[d0],0,0,0);
    o[d0]=__builtin_amdgcn_mfma_f32_32x32x16_bf16(pa2,PK(2),o[d0],0,0,0);
    o[d0]=__builtin_amdgcn_mfma_f32_32x32x16_bf16(pa3,PK(3),o[d0],0,0,0);
    #undef PK
  }
}

#ifndef ATTN_STORE16
#define ATTN_STORE16(p,v) (*(u32x4*)(p)=(v))
#endif
struct AttnJob { const bf16*Q; const bf16*K; const bf16*V; bf16*O; int qrow0, ctxrow0, bandrow0, NT, qpos0, kpos0; float sink2; int has_sink; };
template<int THRL,bool MASK> __device__ __forceinline__ void attn_unit(const AttnJob J,char*shm){
  int tid_=threadIdx.x; asm volatile("":"+v"(tid_)); const int tid=tid_,lane=tid&63,r32=lane&31,hi=lane>>5; const int wid=__builtin_amdgcn_readfirstlane(tid>>6);
  const bf16*Qw=J.Q+(long)(J.qrow0+wid*QBLK)*QP;
  const bf16*Kh=J.K,*Vh=J.V;
  const unsigned lds0=(unsigned)(uintptr_t)shm;
  float*wsf=(float*)(shm+LDS_WS)+wid*64;
  const bf16*ksrc=Kh+(long)lane*QP+wid*8;
  const bf16*vsrc=Vh+(long)(16*(wid&3)+(lane>>2))*QP+(wid>>2)*32+(lane&3)*8;
  const unsigned kdst=lds0+LDS_K+wid*1024, vdst=lds0+LDS_V+wid*1024;
  #define TROW(t) ((long)(((t)<4)?(J.ctxrow0+64*(t)):(J.bandrow0+64*((t)-4))))
  #define DMA_K(t,slot) glds16(ksrc+TROW(t)*QP,(unsigned)__builtin_amdgcn_readfirstlane(kdst+(slot)))
  #define DMA_V(t,slot) glds16(vsrc+TROW(t)*QP,(unsigned)__builtin_amdgcn_readfirstlane(vdst+(slot)))
  const int vb0=(int)(lds0+LDS_V)+((lane>>4)&1)*32+(lane&3)*8+(4*hi+((lane&15)>>2))*64;
  const char*Kbase=shm+LDS_K; bf16x8 kf[8];
  const lds_cptr shm3=(lds_cptr)shm; const lds_cptr kp0=shm3+LDS_K+hi*1024+r32*16; const lds_cptr vp0=shm3+LDS_V+((lane>>4)&1)*32+(lane&3)*8+(4*hi+((lane&15)>>2))*64;
  const int NT=J.NT;
  DMA_K(0,0);DMA_V(0,0);DMA_K(1,SLOTB);
  bf16x8 qr[4];
  #pragma unroll
  for(int d0=0;d0<4;++d0)qr[d0]=*reinterpret_cast<const bf16x8*>(&Qw[(long)r32*QP+d0*16+hi*8]);
  float mhat=0.f,l_reg=0.f;f32x16 o[2];o[0]=f32x16{};o[1]=f32x16{};f32x16 negm=f32x16{};asm volatile("":"+v"(negm));
  const int qpos=J.qpos0+wid*QBLK+r32;
  #define CMASK(P0,P1,t) do{ if constexpr(MASK){ if((t)>=4) wmask(P0,P1,J.kpos0+64*((t)-4)+4*hi,qpos); } }while(0)
  bool resc=false;
  #define START(P0,P1) do{ const float rm=rowmax(P0,P1); resc=false; \
    { const float dl=rm; mhat=fadd_s(mhat,dl); \
      _Pragma("unroll") for(int r=0;r<16;++r){P0[r]=fsub_s(P0[r],dl);P1[r]=fsub_s(P1[r],dl);} \
      _Pragma("unroll") for(int r=0;r<16;++r)negm[r]=-mhat; asm volatile("":"+v"(negm)); } \
    _Pragma("unroll") for(int r=0;r<16;++r)P0[r]=__builtin_amdgcn_exp2f(P0[r]); }while(0)
  #define RESC() do{ if(resc){ asm volatile("s_waitcnt lgkmcnt(0)":::"memory"); \
      _Pragma("unroll") for(int d_=0;d_<2;++d_) _Pragma("unroll") for(int r=0;r<16;++r)o[d_][r]*=wsf[crow(r,hi)]; } }while(0)
  f32x16 pA0,pA1,pB0,pB1;
  int sl_prev=0,sl_cur=0,sl_next=SLOTB;
  #define ROT() do{sl_prev=sl_cur;sl_cur=sl_next;sl_next=(sl_next==(NSLOT-1)*SLOTB)?0:sl_next+SLOTB;}while(0)
  DMA_K(2,2*SLOTB);
  WAIT_BAR(3);
  qkt(pA0,pA1,Kbase,qr,negm,r32,hi);asm volatile("s_nop 15\n\ts_nop 7":"+v"(pA0),"+v"(pA1));CMASK(pA0,pA1,0);
  START(pA0,pA1);
  _Pragma("unroll") for(int r=0;r<16;++r)pA1[r]=__builtin_amdgcn_exp2f(pA1[r]);
  WAIT_BAR(0);
  DMA_K(3,0);DMA_V(1,SLOTB);
  ROT();
  kload8(kf,kp0+sl_cur);
  WAIT_BAR(2);
  s16x4 vlo[8],vhi[8]; u32x4 pw0,pw1,pw2,pw3;
  #define PKW(P,B) cvtpk_s(P[B],P[B+1])
  #define PAF(k) __builtin_bit_cast(bf16x8,pw##k)
  #define VFR(i) (bf16x8){vlo[i][0],vlo[i][1],vlo[i][2],vlo[i][3],vhi[i][0],vhi[i][1],vhi[i][2],vhi[i][3]}
  #define PIN(x) asm volatile("":"+v"(x))
  #define MX3(a,b,c) __builtin_fmaxf(__builtin_fmaxf((a),(b)),(c))
  #define GAPA(MF,A0,A1,A2,A3,W0,W1,PW) do{ MF; sacc+=A0; sacc+=A1; sacc+=A2; sacc+=A3; PIN(sacc); W0; W1; PIN(PW); SBAR(); }while(0)
  #define EX(v) __builtin_amdgcn_exp2f(v)
  #define GAPB(MF,X,B) do{ MF; X[B]=EX(X[B]); X[B+1]=EX(X[B+1]); X[B+2]=EX(X[B+2]); X[B+3]=EX(X[B+3]); PIN(X); SBAR(); }while(0)
  #define VRD(i) do{ vlo[i]=vtr(vp_+(((i)>>2)*4096+((i)&3)*1024)); vhi[i]=vtr(vp_+(((i)>>2)*4096+((i)&3)*1024+512)); }while(0)
  #define KRD(G,j) do{ if(G){ kload2(kf,kp0+sl_next,j); SBAR(); } }while(0)
  #define STEP(C0,C1,P0,P1,t,GK,GV,GL) do{ SBAR(); \
    const lds_cptr vp_=vp0+sl_prev; \
    VRD(0); SBAR(); float sacc=(P0[0]+P0[1]); \
    GAPA(C0=__builtin_amdgcn_mfma_f32_32x32x16_bf16(kf[0],qr[0],negm,0,0,0), P0[2],P0[3],P0[4],P0[5],     pw0[0]=PKW(P0,0), pw0[1]=PKW(P0,2), pw0); \
    VRD(4); SBAR(); GAPA(C1=__builtin_amdgcn_mfma_f32_32x32x16_bf16(kf[1],qr[0],negm,0,0,0), P0[6],P0[7],P0[8],P0[9],     pw0[2]=PKW(P0,4), pw0[3]=PKW(P0,6), pw0); \
    VRD(1); SBAR(); GAPA(C0=__builtin_amdgcn_mfma_f32_32x32x16_bf16(kf[2],qr[1],C0,0,0,0),   P0[10],P0[11],P0[12],P0[13], pw1[0]=PKW(P0,8), pw1[1]=PKW(P0,10), pw1); \
    VRD(5); SBAR(); GAPA(C1=__builtin_amdgcn_mfma_f32_32x32x16_bf16(kf[3],qr[1],C1,0,0,0),   P0[14],P0[15],P1[0],P1[1],   pw1[2]=PKW(P0,12),pw1[3]=PKW(P0,14), pw1); \
    VRD(2); SBAR(); GAPA(C0=__builtin_amdgcn_mfma_f32_32x32x16_bf16(kf[4],qr[2],C0,0,0,0),   P1[2],P1[3],P1[4],P1[5],     pw2[0]=PKW(P1,0), pw2[1]=PKW(P1,2), pw2); \
    VRD(6); SBAR(); GAPA(C1=__builtin_amdgcn_mfma_f32_32x32x16_bf16(kf[5],qr[2],C1,0,0,0),   P1[6],P1[7],P1[8],P1[9],     pw2[2]=PKW(P1,4), pw2[3]=PKW(P1,6), pw2); \
    VRD(3); SBAR(); GAPA(C0=__builtin_amdgcn_mfma_f32_32x32x16_bf16(kf[6],qr[3],C0,0,0,0),   P1[10],P1[11],P1[12],P1[13], pw3[0]=PKW(P1,8), pw3[1]=PKW(P1,10), pw3); \
    VRD(7); SBAR(); GAPA(C1=__builtin_amdgcn_mfma_f32_32x32x16_bf16(kf[7],qr[3],C1,0,0,0),   P1[14],P1[15],0.f,0.f,       pw3[2]=PKW(P1,12),pw3[3]=PKW(P1,14), pw3); \
    l_reg+=sacc; \
    if(GK){DMA_K((t)+3,sl_cur);} if(GV){DMA_V((t)+1,sl_next);} \
    CMASK(C0,C1,t); \
    { float a=MX3(C0[0],C0[1],C1[0]),b=MX3(C0[2],C0[3],C1[1]); a=MX3(a,C1[2],C1[3]); \
      _Pragma("unroll") for(int r=4;r<16;r+=4){a=MX3(a,C0[r],C0[r+1]);b=MX3(b,C0[r+2],C0[r+3]);a=MX3(a,C1[r],C1[r+1]);b=MX3(b,C1[r+2],C1[r+3]);} \
      float rm=__builtin_fmaxf(a,b); { auto rr=__builtin_amdgcn_permlane32_swap(__float_as_uint(rm),__float_as_uint(rm),false,false); rm=__builtin_fmaxf(__uint_as_float(rr[0]),__uint_as_float(rr[1])); } \
      resc=false; \
      if(__builtin_expect(__any(rm>(float)THRL),0)){ const float dl=__builtin_fmaxf(rm,0.f); mhat+=dl; \
        _Pragma("unroll") for(int r=0;r<16;++r){C0[r]-=dl;C1[r]-=dl;} \
        _Pragma("unroll") for(int r=0;r<16;++r)negm[r]=-mhat; asm volatile("":"+v"(negm)); \
        const float f=__builtin_amdgcn_exp2f(-dl); l_reg*=f; if(hi==0)wsf[r32]=f; resc=true; } } \
    SBAR(); \
    GAPB(o[0]=__builtin_amdgcn_mfma_f32_32x32x16_bf16(PAF(0),VFR(0),o[0],0,0,0), C0,0); \
    GAPB(o[1]=__builtin_amdgcn_mfma_f32_32x32x16_bf16(PAF(0),VFR(4),o[1],0,0,0), C0,4); \
    KRD(GL,0); GAPB(o[0]=__builtin_amdgcn_mfma_f32_32x32x16_bf16(PAF(1),VFR(1),o[0],0,0,0), C0,8); \
    KRD(GL,1); GAPB(o[1]=__builtin_amdgcn_mfma_f32_32x32x16_bf16(PAF(1),VFR(5),o[1],0,0,0), C0,12); \
    KRD(GL,2); GAPB(o[0]=__builtin_amdgcn_mfma_f32_32x32x16_bf16(PAF(2),VFR(2),o[0],0,0,0), C1,0); \
    KRD(GL,3); GAPB(o[1]=__builtin_amdgcn_mfma_f32_32x32x16_bf16(PAF(2),VFR(6),o[1],0,0,0), C1,4); \
    GAPB(o[0]=__builtin_amdgcn_mfma_f32_32x32x16_bf16(PAF(3),VFR(3),o[0],0,0,0), C1,8); \
    GAPB(o[1]=__builtin_amdgcn_mfma_f32_32x32x16_bf16(PAF(3),VFR(7),o[1],0,0,0), C1,12); \
    }while(0)
  int t=1;
  for(;t+5<NT;t+=2){
    STEP(pB0,pB1,pA0,pA1,t,true,true,true);     WAIT_BAR(2); RESC(); ROT();
    STEP(pA0,pA1,pB0,pB1,t+1,true,true,true);   WAIT_BAR(2); RESC(); ROT();
  }
  #define ENDW(tt) do{ if((tt)+3<NT){WAIT_BAR(2);} else if((tt)+2<NT){WAIT_BAR(1);} else {WAIT_BAR(0);} }while(0)
  for(;t+1<NT;t+=2){
    STEP(pB0,pB1,pA0,pA1,t,(t+3<NT),(t+1<NT),(t+1<NT));       ENDW(t);   RESC(); ROT();
    STEP(pA0,pA1,pB0,pB1,t+1,(t+4<NT),(t+2<NT),(t+2<NT));     ENDW(t+1); RESC(); ROT();
  }
  STEP(pB0,pB1,pA0,pA1,NT-1,false,false,false); RESC();
  { float sacc=pB0[0]+pB0[1]; _Pragma("unroll") for(int r=2;r<16;++r)sacc+=pB0[r]; _Pragma("unroll") for(int r=0;r<16;++r)sacc+=pB1[r]; l_reg+=sacc;
    pw0=(u32x4){PKW(pB0,0),PKW(pB0,2),PKW(pB0,4),PKW(pB0,6)};pw1=(u32x4){PKW(pB0,8),PKW(pB0,10),PKW(pB0,12),PKW(pB0,14)};pw2=(u32x4){PKW(pB1,0),PKW(pB1,2),PKW(pB1,4),PKW(pB1,6)};pw3=(u32x4){PKW(pB1,8),PKW(pB1,10),PKW(pB1,12),PKW(pB1,14)};
    SBAR(); pv(o,vb0+sl_cur,PAF(0),PAF(1),PAF(2),PAF(3)); }
  #undef PKW
  #undef PAF
  #undef VFR
  #undef PIN
  #undef MX3
  #undef GAPA
  #undef GAPB
  #undef EX
  #undef VRD
  #undef KRD
  #undef STEP
  #undef ENDW
  {auto rr=__builtin_amdgcn_permlane32_swap(__float_as_uint(l_reg),__float_as_uint(l_reg),false,false);l_reg=__uint_as_float(rr[0])+__uint_as_float(rr[1]);}
  if(J.has_sink)l_reg+=__builtin_amdgcn_exp2f(J.sink2-mhat);
  if(hi==0)wsf[32+r32]=l_reg;asm volatile("s_waitcnt lgkmcnt(0)":::"memory");
  float rli[16];
  #pragma unroll
  for(int r=0;r<16;++r)rli[r]=__builtin_amdgcn_rcpf(wsf[32+crow(r,hi)]);
  bf16*Ow=J.O+(long)(J.qrow0+wid*QBLK)*OP;
  { bf16*stg=(bf16*)(shm+LDS_OST)+wid*2048;
    #pragma unroll
    for(int r=0;r<16;++r){const int orow=crow(r,hi);
      #pragma unroll
      for(int d0=0;d0<2;++d0)stg[orow*64+d0*32+r32]=__float2bfloat16(o[d0][r]*rli[r]);}
    asm volatile("s_waitcnt lgkmcnt(0)":::"memory");
    #pragma unroll
    for(int i=0;i<4;++i){const int row=i*8+(lane>>3),ch=lane&7; const u32x4 v=*(const u32x4*)(stg+row*64+ch*8); ATTN_STORE16(Ow+(long)row*OP+ch*8,v);} }
  asm volatile("s_waitcnt lgkmcnt(0)\n\ts_barrier":::"memory");
  #undef DMA_K
  #undef TROW
  #undef DMA_V
  #undef CMASK
  #undef START
  #undef RESC
  #undef ROT
}
constexpr int ATTN_LDS_BYTES=LDS_BYTES;
#undef SBAR
#undef WAIT_BAR
}
#define LAS __attribute__((address_space(3)))
typedef unsigned short bf16_t;
typedef float f32x4 __attribute__((ext_vector_type(4)));
typedef unsigned u32x4 __attribute__((ext_vector_type(4)));
typedef unsigned u32x2 __attribute__((ext_vector_type(2)));
typedef float cf2 __attribute__((ext_vector_type(2)));
__device__ __forceinline__ cf2 mk2(float x, float y) { cf2 r; r.x = x; r.y = y; return r; }
constexpr int DM = 1024, NBATCH = 2, SEQ = 16384, DEPTH = 4, CTXL = 256, DFF = 2816, DIN = 2304, NMODV = 9 * 1024;
constexpr int MLAT = NBATCH * SEQ, MTOT = MLAT + NBATCH * CTXL;
constexpr int PBP = 1280;
constexpr float EPSF = 1e-6f;
constexpr float QC2 = 0.125f * 1.4426950408889634f;
constexpr float LOG2E = 1.4426950408889634f;
constexpr int NTHREADS = 512, NWAVES = 8;
constexpr int LDS_BYTES = 147456;
constexpr size_t MiB = 1u << 20;
constexpr size_t WS_MOD = 1 * MiB, WS_TW14 = 2 * MiB, WS_TW15 = 2 * MiB + 131072, WS_TWA = 2 * MiB + 262144, WS_TWB = 2 * MiB + 393216, WS_H2 = 3 * MiB, WS_H2C = 7 * MiB, WS_XC = 8 * MiB;
constexpr size_t WS_W13A = 10 * MiB, WS_W13B = 21 * MiB, WS_W2A = 32 * MiB, WS_W2B = WS_W2A + 5767168, WS_WIN = 43 * MiB, WS_WOUT = WS_WIN + 4718592, WS_WLRU = WS_WOUT + 2 * MiB;
constexpr size_t WS_XN = 50 * MiB;
constexpr size_t WS_SCR = 116 * MiB;
constexpr size_t WS_H = WS_SCR;
constexpr size_t WS_PB = WS_SCR, WS_R = 198 * MiB, WS_UT = 215 * MiB, WS_KF = 311 * MiB, WS_AB = 375 * MiB, WS_PA = WS_AB;
constexpr size_t WS_UC = 505 * MiB;
constexpr size_t WS_SUM = 507 * MiB, WS_CAR = 508 * MiB;
constexpr size_t WS_PART = 509 * MiB;
constexpr size_t WS_RAW0 = WS_KF, WS_RAW1 = 532 * MiB;
constexpr size_t WS_END = 565 * MiB;
static_assert(WS_WLRU + 524288 <= WS_XN && WS_XN + (size_t)MTOT * 1024 * 2 <= WS_SCR && WS_H + (size_t)MTOT * DFF * 2 <= WS_END, "ws map");
static_assert(WS_PB + (size_t)MTOT * PBP * 2 <= WS_R && WS_R + (size_t)MTOT * 256 * 2 <= WS_UT && WS_UT + (size_t)6 * 256 * SEQ * 4 <= WS_KF && WS_KF + (size_t)256 * 262144 <= WS_AB && WS_AB + (size_t)2 * MTOT * 256 * 8 <= WS_END, "ws map 2");

struct Args { const float* in[32]; float* out; unsigned char* ws; };
typedef const Args __attribute__((address_space(4)))* ArgsP;
__device__ __forceinline__ ArgsP args_ptr() { ArgsP p = (ArgsP)__builtin_amdgcn_kernarg_segment_ptr(); asm volatile("" : "+s"(p)); return p; }
enum { I_X = 0, I_C, I_CTX, I_CCTX, I_WMOD, I_BMOD, I_NORMG, I_F1W13, I_F1W2, I_F2W13, I_F2W2, I_WIN, I_WOUT, I_HYCW, I_HYCB, I_HYW1, I_HYB1, I_HYFREQ, I_HYW2, I_HYB2, I_HYW3, I_HYSKIP,
       I_LRUCW, I_LRUCB, I_LRUWA, I_LRUBA, I_LRUWX, I_LRUBX, I_LRULAM, I_SINK, I_QKGAIN, I_FINALG };

__device__ __forceinline__ unsigned f2bf(float f) { unsigned u = __float_as_uint(f); return (u + 0x7fffu + ((u >> 16) & 1u)) >> 16; }
__device__ __forceinline__ unsigned pk2(float lo, float hi) { return f2bf(lo) | (f2bf(hi) << 16); }
__device__ __forceinline__ float bflo(unsigned w) { return __uint_as_float(w << 16); }
__device__ __forceinline__ float bfhi(unsigned w) { return __uint_as_float(w & 0xffff0000u); }
__device__ __forceinline__ float bf2f(bf16_t h) { return __uint_as_float(((unsigned)h) << 16); }
__device__ __forceinline__ float wave_sum(float v) {
#pragma unroll
    for (int o = 1; o < 64; o <<= 1) v += __shfl_xor(v, o);
    return v;
}
__device__ __forceinline__ void unpack8(const u32x4 w, float (&v)[8]) { v[0] = bflo(w.x); v[1] = bfhi(w.x); v[2] = bflo(w.y); v[3] = bfhi(w.y); v[4] = bflo(w.z); v[5] = bfhi(w.z); v[6] = bflo(w.w); v[7] = bfhi(w.w); }
__device__ __forceinline__ u32x4 pack8(const float (&v)[8]) { u32x4 w; w.x = pg8::cvt_pk_bf16(v[0], v[1]); w.y = pg8::cvt_pk_bf16(v[2], v[3]); w.z = pg8::cvt_pk_bf16(v[4], v[5]); w.w = pg8::cvt_pk_bf16(v[6], v[7]); return w; }
__device__ __forceinline__ float* xrow_ptr(ArgsP a, int row) { return row < MLAT ? a->out + (size_t)row * DM : (float*)(a->ws + WS_XC) + (size_t)(row - MLAT) * DM; }
__device__ __forceinline__ int mod_index(int row) { return row < MLAT ? (row >> 14) : 2; }
__device__ __forceinline__ float sigmoidf_(float x) { return 1.f / (1.f + __expf(-x)); }

struct EpiSwiGLU {
    static constexpr bool PERM = true, AFTER_DRAIN = false;
    bf16_t* H;
    __device__ __forceinline__ void operator()(const pg8::f32x4 (&acc)[2][2][4][2], const pg8::Unit& u, int wr, int wc, int fr, int fq) const {
#ifndef STUB_EpiSwiGLU
        const int row0 = u.pm * 256 + wr * 64 + fr, col0 = u.pn * 128 + wc * 32 + 8 * fq;
#pragma unroll
        for (int ai = 0; ai < 2; ++ai)
#pragma unroll
            for (int m = 0; m < 4; ++m) {
                float v[8];
#pragma unroll
                for (int n = 0; n < 2; ++n)
#pragma unroll
                    for (int i = 0; i < 4; ++i) { const float g = acc[ai][0][m][n][i], up = acc[ai][1][m][n][i]; v[4 * n + i] = g * __builtin_amdgcn_rcpf(1.f + __expf(-g)) * up; }
                *(u32x4*)(H + (size_t)(row0 + ai * 128 + m * 16) * DFF + col0) = pack8(v);
            }
#endif
    }
};
struct EpiResid {
    static constexpr bool PERM = false, AFTER_DRAIN = false;
    float* Xlat; float* Xctx; const float* gate; float gs; const float* Xin;
    __device__ __forceinline__ void operator()(const pg8::f32x4 (&acc)[2][2][4][2], const pg8::Unit& u, int wr, int wc, int fr, int fq) const {
#ifndef STUB_EpiResid
        const int mi = u.pm < 128 ? (u.pm >> 6) : 2;
        float* base = u.pm < 128 ? Xlat + (size_t)u.pm * 256 * DM : Xctx + (size_t)(u.pm - 128) * 256 * DM;
        const float* rbase = u.pm < 128 ? Xin + (size_t)u.pm * 256 * DM : base;
#pragma unroll
        for (int bj = 0; bj < 2; ++bj)
#pragma unroll
            for (int n = 0; n < 2; ++n) {
                const int c = 256 * u.pn + 128 * bj + 32 * wc + 16 * n + 4 * fq;
                const f32x4 gv = *(const f32x4*)(gate + (size_t)mi * NMODV + c) * gs;
#pragma unroll
                for (int ai = 0; ai < 2; ++ai)
#pragma unroll
                    for (int m = 0; m < 4; ++m) { const size_t off = (size_t)(128 * ai + 64 * wr + 16 * m + fr) * DM + c; *(f32x4*)(base + off) = *(const f32x4*)(rbase + off) + gv * acc[ai][bj][m][n]; if (m & 1) asm volatile("" ::: "memory"); }
            }
#endif
    }
};
struct EpiResidCtxSplitK {
    static constexpr bool PERM = false, AFTER_DRAIN = false;
    float* PART; const float* gate; float gs; int nNr;
    __device__ __forceinline__ void operator()(const pg8::f32x4 (&acc)[2][2][4][2], const pg8::Unit& u, int wr, int wc, int fr, int fq) const {
        const int pn = u.pn % nNr, ks = u.pn / nNr; const int c0 = 256 * pn + 32 * wc + 4 * fq;
        f32x4 gv[2][2];
#pragma unroll
        for (int bj = 0; bj < 2; ++bj)
#pragma unroll
            for (int n = 0; n < 2; ++n) gv[bj][n] = *(const f32x4*)(gate + (size_t)2 * NMODV + c0 + 128 * bj + 16 * n) * gs;
        float* base = PART + ((size_t)ks * (NBATCH * CTXL) + u.pm * 256 + 64 * wr + fr) * DM + c0;
#pragma unroll
        for (int ai = 0; ai < 2; ++ai)
#pragma unroll
            for (int m = 0; m < 4; ++m) {
                float* p = base + (size_t)(128 * ai + 16 * m) * DM;
#pragma unroll
                for (int bj = 0; bj < 2; ++bj)
#pragma unroll
                    for (int n = 0; n < 2; ++n) *(f32x4*)(p + 128 * bj + 16 * n) = gv[bj][n] * acc[ai][bj][m][n];
            }
    }
};
struct EpiProj {
    static constexpr bool PERM = true, AFTER_DRAIN = false;
    bf16_t* PA; bf16_t* PB;
    __device__ __forceinline__ void operator()(const pg8::f32x4 (&acc)[2][2][4][2], const pg8::Unit& u, int wr, int wc, int fr, int fq) const {
#ifndef STUB_EpiProj
        bf16_t* O = u.pn < 4 ? PA : PB; const int ldc = u.pn < 4 ? 1024 : PBP; const int cb = (u.pn < 4 ? u.pn : u.pn - 4) * 256 + wc * 32 + 8 * fq;
        const int row0 = u.pm * 256 + wr * 64 + fr;
#pragma unroll
        for (int ai = 0; ai < 2; ++ai)
#pragma unroll
            for (int m = 0; m < 4; ++m)
#pragma unroll
                for (int bj = 0; bj < 2; ++bj) {
                    float v[8];
#pragma unroll
                    for (int n = 0; n < 2; ++n)
#pragma unroll
                        for (int i = 0; i < 4; ++i) v[4 * n + i] = acc[ai][bj][m][n][i];
                    *(u32x4*)(O + (size_t)(row0 + ai * 128 + m * 16) * ldc + cb + bj * 128) = pack8(v);
                }
#endif
    }
};
struct EpiLru {
    static constexpr bool PERM = true, AFTER_DRAIN = false;
    unsigned* RAW0; unsigned* RAW1;
    __device__ __forceinline__ void operator()(const pg8::f32x4 (&acc)[2][2][4][2], const pg8::Unit& u, int wr, int wc, int fr, int fq) const {
#ifndef STUB_EpiLru
        const int dir = u.pn >> 1, ch0 = (u.pn & 1) * 128 + wc * 32 + 8 * fq;
        const int row0 = u.pm * 256 + wr * 64 + fr;
        unsigned* R = dir ? RAW1 : RAW0;
#pragma unroll
        for (int ai = 0; ai < 2; ++ai)
#pragma unroll
            for (int m = 0; m < 4; ++m) {
                unsigned* o = R + (size_t)(row0 + ai * 128 + m * 16) * 256 + ch0;
#pragma unroll
                for (int n = 0; n < 2; ++n) {
                    const f32x4 pa = acc[ai][0][m][n], px = acc[ai][1][m][n];
                    u32x4 w; w.x = pg8::cvt_pk_bf16(pa[0], px[0]); w.y = pg8::cvt_pk_bf16(pa[1], px[1]); w.z = pg8::cvt_pk_bf16(pa[2], px[2]); w.w = pg8::cvt_pk_bf16(pa[3], px[3]);
                    *(u32x4*)(o + 4 * n) = w;
                }
            }
#endif
    }
};
constexpr int LCH = 130, NCH = 128;
#define LRU_ROWOF(p, b, dir) ((p) < CTXL ? (size_t)MLAT + (b) * CTXL + ((dir) ? (CTXL - 1 - (p)) : (p)) : (size_t)(b) * SEQ + ((dir) ? (SEQ - 1 - ((p) - CTXL)) : ((p) - CTXL)))
__device__ __forceinline__ void lru_gate_phase(ArgsP a, int l, int tid) {
    cf2* AB = (cf2*)(a->ws + WS_AB); const bf16_t* R = (const bf16_t*)(a->ws + WS_R); cf2* SUM = (cf2*)(a->ws + WS_SUM);
    const int ch = tid & 255, half = tid >> 8;
    for (int u = blockIdx.x; u < 256; u += gridDim.x) {
        const int dir = u >> 7, b = (u >> 6) & 1, chunk = (u & 63) * 2 + half;
        const float vba = a->in[I_LRUBA][(size_t)l * 512 + dir * 256 + ch], vbx = a->in[I_LRUBX][(size_t)l * 512 + dir * 256 + ch];
        const float sp8 = -8.f * log1pf(expf(-a->in[I_LRULAM][(size_t)l * 512 + dir * 256 + ch]));
        unsigned* ABd = (unsigned*)AB + (size_t)dir * MTOT * 256 + ch; const bf16_t* Rc = R + ch; const unsigned* RWd = (const unsigned*)(a->ws + (dir ? WS_RAW1 : WS_RAW0)) + ch;
        float Ac = 1.f, h = 0.f;
#pragma unroll 1
        for (int s0 = 0; s0 < LCH; s0 += 10) {
            cf2 raw[10]; float uu[10];
#pragma unroll
            for (int j = 0; j < 10; ++j) { const size_t row = LRU_ROWOF(chunk * LCH + s0 + j, b, dir); const unsigned w = RWd[row * 256]; raw[j] = mk2(bflo(w), bfhi(w)); uu[j] = bf2f(Rc[row * 256]); }
#pragma unroll
            for (int j = 0; j < 10; ++j) {
                const float ra = __builtin_amdgcn_rcpf(1.f + __expf(-(raw[j].x + vba))), ri = __builtin_amdgcn_rcpf(1.f + __expf(-(raw[j].y + vbx)));
                const float la = ra * sp8; const float av = __expf(la); const float bv = __builtin_amdgcn_sqrtf(fmaxf(__builtin_fmaf(-av, av, 1.0f), 0.f)) * ri * uu[j];
                h = av * h + bv; Ac *= av;
                const size_t row = LRU_ROWOF(chunk * LCH + s0 + j, b, dir); ABd[row * 256] = pg8::cvt_pk_bf16(Ac, h);
            }
        }
        SUM[((size_t)((dir * 2 + b) * NCH + chunk)) * 256 + ch] = mk2(Ac, h);
    }
}
__device__ __forceinline__ void lru_carry_unit(ArgsP a, int db, int tid) {
    if (tid < 256) {
        const cf2* SUM = (const cf2*)(a->ws + WS_SUM) + (size_t)db * NCH * 256 + tid; float* CAR = (float*)(a->ws + WS_CAR) + (size_t)db * NCH * 256 + tid;
        float c = 0.f;
#pragma unroll 1
        for (int k0 = 0; k0 < NCH; k0 += 8) {
            cf2 e[8];
#pragma unroll
            for (int j = 0; j < 8; ++j) e[j] = SUM[(size_t)(k0 + j) * 256];
#pragma unroll
            for (int j = 0; j < 8; ++j) { CAR[(size_t)(k0 + j) * 256] = c; c = e[j].x * c + e[j].y; }
        }
    }
}
typedef short sbf16x8 __attribute__((ext_vector_type(8)));
typedef float sf32x16 __attribute__((ext_vector_type(16)));
__device__ __forceinline__ int crow32(int r, int hi) { return (r & 3) + 8 * (r >> 2) + 4 * hi; }
template <int NB> __device__ __forceinline__ void wave_gemm32(const bf16_t* A, const bf16_t* B0, const bf16_t* B1, int K, int lane, sf32x16 (&acc)[NB]) {
    const int r = lane & 31, kh = lane >> 5;
    const bf16_t* pa = A + (size_t)r * K + 8 * kh; const bf16_t* pb0 = B0 + (size_t)r * K + 8 * kh; const bf16_t* pb1 = B1 + (size_t)r * K + 8 * kh;
#pragma unroll
    for (int n = 0; n < NB; ++n)
#pragma unroll
        for (int e = 0; e < 16; ++e) acc[n][e] = 0.f;
#pragma unroll 1
    for (int k = 0; k < K; k += 128) {
        sbf16x8 av[8], bv0[8], bv1[8];
#pragma unroll
        for (int j = 0; j < 8; ++j) { av[j] = *(const sbf16x8*)(pa + k + 16 * j); bv0[j] = *(const sbf16x8*)(pb0 + k + 16 * j); if (NB == 2) bv1[j] = *(const sbf16x8*)(pb1 + k + 16 * j); }
#pragma unroll
        for (int j = 0; j < 8; ++j) { acc[0] = __builtin_amdgcn_mfma_f32_32x32x16_bf16(av[j], bv0[j], acc[0], 0, 0, 0); if (NB == 2) acc[NB - 1] = __builtin_amdgcn_mfma_f32_32x32x16_bf16(av[j], bv1[j], acc[NB - 1], 0, 0, 0); }
    }
}
template <int KIND> __device__ __forceinline__ void ctx_gemm(ArgsP a, const bf16_t* A, const bf16_t* Bt, int K, int ncb, const float* gate, float gs, int tid) {
    const int lane = tid & 63, wave = tid >> 6, hi = lane >> 5, c = lane & 31;
    const int gw = blockIdx.x * NWAVES + wave, NGW = gridDim.x * NWAVES;
    unsigned char* ws = a->ws;
    for (int wt = gw; wt < 16 * ncb; wt += NGW) {
        const int cb = wt >> 4, rb = wt & 15; const int row0 = MLAT + 32 * rb;
        const bf16_t* Ar = A + (size_t)row0 * K;
        if (KIND == 0) {
            const int f0 = 32 * cb; const bf16_t* B0 = Bt + (size_t)(256 * (f0 >> 7) + (f0 & 127)) * K;
            sf32x16 acc[2]; wave_gemm32<2>(Ar, B0, B0 + (size_t)128 * K, K, lane, acc);
            bf16_t* H = (bf16_t*)(ws + WS_H);
#pragma unroll
            for (int r = 0; r < 16; ++r) { const float g = acc[0][r], up = acc[1][r]; H[(size_t)(row0 + crow32(r, hi)) * DFF + f0 + c] = (bf16_t)f2bf(g * __builtin_amdgcn_rcpf(1.f + __expf(-g)) * up); }
        } else if (KIND == 1) {
            const int col = 32 * cb + c; const bf16_t* B0 = Bt + (size_t)(32 * cb) * K;
            sf32x16 acc[1]; wave_gemm32<1>(Ar, B0, B0, K, lane, acc);
            float* X = (float*)(ws + WS_XC); const float gv = gs * gate[(size_t)2 * NMODV + col];
#pragma unroll
            for (int r = 0; r < 16; ++r) { float* p = X + (size_t)(32 * rb + crow32(r, hi)) * DM + col; *p = *p + gv * acc[0][r]; }
        } else if (KIND == 2) {
            const int col0 = 32 * cb; const bf16_t* B0 = Bt + (size_t)col0 * K;
            sf32x16 acc[1]; wave_gemm32<1>(Ar, B0, B0, K, lane, acc);
            bf16_t* O = col0 < 1024 ? (bf16_t*)(ws + WS_PA) + col0 + c : (bf16_t*)(ws + WS_PB) + (col0 - 1024) + c; const int ldc = col0 < 1024 ? 1024 : PBP;
#pragma unroll
            for (int r = 0; r < 16; ++r) O[(size_t)(row0 + crow32(r, hi)) * ldc] = (bf16_t)f2bf(acc[0][r]);
        } else {
            const int dir = cb >> 3, ch0 = (cb & 7) * 32, pn = dir * 2 + (ch0 >> 7); const bf16_t* B0 = Bt + (size_t)(256 * pn + (ch0 & 127)) * K;
            sf32x16 acc[2]; wave_gemm32<2>(Ar, B0, B0 + (size_t)128 * K, K, lane, acc);
            cf2* AB = (cf2*)(ws + WS_AB) + (size_t)dir * MTOT * 256 + ch0 + c;
#pragma unroll
            for (int r = 0; r < 16; ++r) AB[(size_t)(row0 + crow32(r, hi)) * 256] = mk2(acc[0][r], acc[1][r]);
        }
    }
}
#define XB_TMO      128
#define XB_XCNT(j)  (256  + 64 * (j))
#define XB_XSUB(j)  (1280 + 64 * (j))
#define XB_XGEN(j)  (2304 + 64 * (j))
#define XB_TOP      3328
#define XB_TOPGEN   3392
#define XCD_BAR_WORDS 3456
#define XB_SPIN_CAP (1u << 18)

__device__ __forceinline__ unsigned xb_ld(unsigned* p)              { return __hip_atomic_load(p, __ATOMIC_RELAXED, __HIP_MEMORY_SCOPE_AGENT); }
__device__ __forceinline__ unsigned xb_add(unsigned* p, unsigned v) { return __hip_atomic_fetch_add(p, v, __ATOMIC_RELAXED, __HIP_MEMORY_SCOPE_AGENT); }
__device__ __forceinline__ unsigned xb_xcc_id() { return (unsigned)__builtin_amdgcn_s_getreg((3 << 11) | 20) & 0xFu; }
#define XB_SPIN(cond, bar) do { unsigned _sp = 0; while (cond) { __builtin_amdgcn_s_sleep(1); \
    if ((++_sp & 255u) == 0u) { if (xb_ld(&(bar)[XB_TMO])) break; if (_sp > XB_SPIN_CAP) { atomicAdd(&(bar)[XB_TMO], 1u); break; } } } } while (0)

struct XcdBarrier {
    unsigned* bar; unsigned x;
    volatile LAS unsigned* st;
};

__device__ __forceinline__ XcdBarrier xcd_barrier_post(unsigned* bar, volatile LAS unsigned* st) {
    XcdBarrier b; b.bar = bar; b.x = xb_xcc_id(); b.st = st;
    if (threadIdx.x == 0) (void)xb_add(&bar[XB_XCNT(b.x)], 1u);
    return b;
}
__device__ __forceinline__ void xcd_barrier_complete(unsigned* bar, unsigned x, unsigned& nloc, unsigned& nx) {
    const unsigned G = gridDim.x * gridDim.y * gridDim.z;
    unsigned sum, cnt, mine, sp = 0u;
    for (;;) {
        sum = 0u; cnt = 0u; mine = 0u;
#pragma unroll
        for (unsigned j = 0; j < 16; ++j) { const unsigned c = xb_ld(&bar[XB_XCNT(j)]); sum += c; cnt += (c > 0u) ? 1u : 0u; mine = (j == x) ? c : mine; }
        if (sum == G) break;
        __builtin_amdgcn_s_sleep(1);
        if ((++sp & 255u) == 0u) { if (xb_ld(&bar[XB_TMO])) break; if (sp > XB_SPIN_CAP) { atomicAdd(&bar[XB_TMO], 1u); break; } }
    }
    nloc = mine > 0u ? mine : 1u; nx = cnt > 0u ? cnt : 1u;
}

__device__ __forceinline__ void xcd_barrier(const XcdBarrier& b) {
    asm volatile("s_waitcnt vmcnt(0)" ::: "memory");
    __syncthreads();
    if (threadIdx.x == 0) {
        unsigned* bar = b.bar;
        __builtin_amdgcn_s_waitcnt(0);
        unsigned nloc = b.st[0], nx = b.st[1];
        if (nloc == 0u) { xcd_barrier_complete(bar, b.x, nloc, nx); b.st[0] = nloc; b.st[1] = nx; }
        const unsigned old = xb_add(&bar[XB_XSUB(b.x)], 1u);
        const unsigned gen = old / nloc;
        if (old + 1u == (gen + 1u) * nloc) {
            __builtin_amdgcn_fence(__ATOMIC_RELEASE, "agent");
            asm volatile("s_waitcnt vmcnt(0)" ::: "memory");
            const unsigned og = xb_add(&bar[XB_TOP], 1u);
            const unsigned tg = og / nx;
            if (og + 1u == (tg + 1u) * nx) xb_add(&bar[XB_TOPGEN], 1u);
            else XB_SPIN(xb_ld(&bar[XB_TOPGEN]) == tg, bar);
            __builtin_amdgcn_fence(__ATOMIC_ACQUIRE, "agent");
            xb_add(&bar[XB_XGEN(b.x)], 1u);
            asm volatile("s_waitcnt vmcnt(0)" ::: "memory");
        } else {
            XB_SPIN(xb_ld(&bar[XB_XGEN(b.x)]) == gen, bar);
            __builtin_amdgcn_fence(__ATOMIC_ACQUIRE, "agent");
            asm volatile("s_waitcnt vmcnt(0)" ::: "memory");
        }
    }
    __syncthreads();
}
__device__ __forceinline__ void transpose_item(const float* W, int K, int N, bf16_t* WT, int k0, int n0, int drow0, LAS float* scr, int lane) {
#pragma unroll 8
    for (int i = 0; i < 32; ++i) { const int kk = 2 * i + (lane >> 5); scr[kk * 33 + (lane & 31)] = W[(size_t)(k0 + kk) * N + n0 + (lane & 31)]; }
    asm volatile("s_waitcnt lgkmcnt(0)" ::: "memory");
    const int c = lane & 7;
#pragma unroll
    for (int j = 0; j < 4; ++j) { const int n = (lane >> 3) + 8 * j; const LAS float* s = scr + (8 * c) * 33 + n;
        u32x4 o; o.x = pk2(s[0 * 33], s[1 * 33]); o.y = pk2(s[2 * 33], s[3 * 33]); o.z = pk2(s[4 * 33], s[5 * 33]); o.w = pk2(s[6 * 33], s[7 * 33]);
        *(u32x4*)(WT + (size_t)(drow0 + n) * K + k0 + 8 * c) = o; }
    asm volatile("s_waitcnt lgkmcnt(0)" ::: "memory");
}
__device__ __forceinline__ int w13_drow(int c) { return c < DFF ? 256 * (c >> 7) + (c & 127) : 256 * ((c - DFF) >> 7) + 128 + ((c - DFF) & 127); }

__device__ __forceinline__ void h2_row(ArgsP a, int l, int t, int n, float* dst, size_t dstride, int lane) {
    const float tt = (float)t / (float)(n - 1);
    const float w = (float)(2.0 * 3.14159265358979323846) * (float)t / (float)n;
    float z = 0.f;
    if (lane == 0) z = tt;
    else if (lane <= 16) { const float f = 1e-4f + (float)(lane - 1) * ((15.0f - 1e-4f) / 15.0f); z = cosf(f * w); }
    else if (lane <= 32) { const float f = 1e-4f + (float)(lane - 17) * ((15.0f - 1e-4f) / 15.0f); z = -sinf(f * w); }
    const float* w1 = a->in[I_HYW1] + (size_t)l * 33 * 64; const float* w2 = a->in[I_HYW2] + (size_t)l * 64 * 64;
    float h1 = a->in[I_HYB1][l * 64 + lane];
#pragma unroll
    for (int i = 0; i < 33; ++i) h1 += __shfl(z, i) * w1[i * 64 + lane];
    h1 = sinf(a->in[I_HYFREQ][(l * 2 + 0) * 64 + lane] * h1);
    float h2 = a->in[I_HYB2][l * 64 + lane];
#pragma unroll 8
    for (int i = 0; i < 64; ++i) h2 += __shfl(h1, i) * w2[i * 64 + lane];
    h2 = sinf(a->in[I_HYFREQ][(l * 2 + 1) * 64 + lane] * h2);
    dst[(size_t)lane * dstride] = h2;
}

__device__ __forceinline__ void prep_layer(ArgsP a, int l, LAS unsigned char* lds, int tid, int wave, int lane) {
    LAS float* scr = (LAS float*)(lds + wave * 16384);
    const int gw = blockIdx.x * NWAVES + wave, NGW = gridDim.x * NWAVES;
    unsigned char* ws = a->ws;
    constexpr int I13 = 16 * 176, I2 = 44 * 32, IIN = 16 * 72, IOUT = 16 * 32, NIT = 2 * I13 + 2 * I2 + IIN + IOUT;
    for (int it = gw; it < NIT; it += NGW) {
        int r = it;
        if (r < 2 * I13) { const int w = r / I13; r -= w * I13; const int kb = r / 176, nb = r % 176;
            transpose_item((w ? a->in[I_F2W13] : a->in[I_F1W13]) + (size_t)l * DM * 2 * DFF, DM, 2 * DFF, (bf16_t*)(ws + (w ? WS_W13B : WS_W13A)), 64 * kb, 32 * nb, w13_drow(32 * nb), scr, lane); continue; }
        r -= 2 * I13;
        if (r < 2 * I2) { const int w = r / I2; r -= w * I2; const int kb = r / 32, nb = r % 32;
            transpose_item((w ? a->in[I_F2W2] : a->in[I_F1W2]) + (size_t)l * DFF * DM, DFF, DM, (bf16_t*)(ws + (w ? WS_W2B : WS_W2A)), 64 * kb, 32 * nb, 32 * nb, scr, lane); continue; }
        r -= 2 * I2;
        if (r < IIN) { const int kb = r / 72, nb = r % 72; transpose_item(a->in[I_WIN] + (size_t)l * DM * DIN, DM, DIN, (bf16_t*)(ws + WS_WIN), 64 * kb, 32 * nb, 32 * nb, scr, lane); continue; }
        r -= IIN;
        { const int kb = r / 32, nb = r % 32; transpose_item(a->in[I_WOUT] + (size_t)l * DM * DM, DM, DM, (bf16_t*)(ws + WS_WOUT), 64 * kb, 32 * nb, 32 * nb, scr, lane); }
    }
    {
        bf16_t* WL = (bf16_t*)(ws + WS_WLRU);
        const int gt = blockIdx.x * NTHREADS + tid, NGT = gridDim.x * NTHREADS;
        for (int idx = gt; idx < 1024 * 32; idx += NGT) {
            const int np = idx >> 5, k0 = (idx & 31) * 8; const int pn = np >> 8, j = np & 255, dir = pn >> 1, mat = j >> 7, ch = (pn & 1) * 128 + (j & 127), blk = ch >> 6, e = ch & 63;
            float v[8];
            const float* src = (mat ? a->in[I_LRUWX] : a->in[I_LRUWA]) + ((((size_t)l * 2 + dir) * 4 + blk) * 64) * 64 + e;
#pragma unroll
            for (int i = 0; i < 8; ++i) { const int k = k0 + i; v[i] = ((k >> 6) == blk) ? src[(size_t)(k & 63) * 64] : 0.f; }
            *(u32x4*)(WL + (size_t)np * 256 + k0) = pack8(v);
        }
    }
    {
        float* H2 = (float*)(ws + WS_H2); float* H2C = (float*)(ws + WS_H2C);
        for (int t = gw; t < SEQ + CTXL; t += NGW) { if (t < SEQ) h2_row(a, l, t, SEQ, H2 + t, SEQ, lane); else h2_row(a, l, t - SEQ, CTXL, H2C + (size_t)(t - SEQ) * 64, 1, lane); }
    }
}

__device__ __forceinline__ void norm_phase(ArgsP a, int l, int k, int wave, int lane, int nsplit = 0, bool from_input = false) {
    const int gw = blockIdx.x * NWAVES + wave, NGW = gridDim.x * NWAVES;
    const float* g = a->in[I_NORMG] + ((size_t)l * 3 + k) * DM; const float* MOD = (const float*)(a->ws + WS_MOD) + (size_t)l * 3 * NMODV;
    bf16_t* XN = (bf16_t*)(a->ws + WS_XN);
    f32x4 gv[4];
#pragma unroll
    for (int j = 0; j < 4; ++j) gv[j] = *(const f32x4*)(g + 4 * lane + 256 * j);
    for (int row = gw; row < MTOT; row += NGW) {
        const float* xr = (from_input && row < MLAT) ? a->in[I_X] + (size_t)row * DM : xrow_ptr(a, row); const int mi = mod_index(row);
        const float* sh = MOD + (size_t)mi * NMODV + (3 * k) * DM; const float* sc = sh + DM;
        f32x4 v[4]; float s = 0.f;
#pragma unroll
        for (int j = 0; j < 4; ++j) v[j] = *(const f32x4*)(xr + 4 * lane + 256 * j);
        if (nsplit > 0 && row >= MLAT) {
            const float* pp = (const float*)(a->ws + WS_PART) + (size_t)(row - MLAT) * DM + 4 * lane;
            for (int ks = 0; ks < nsplit; ++ks) {
#pragma unroll
                for (int j = 0; j < 4; ++j) v[j] = v[j] + *(const f32x4*)(pp + (size_t)ks * (NBATCH * CTXL) * DM + 256 * j);
            }
            float* xw = (float*)xr;
#pragma unroll
            for (int j = 0; j < 4; ++j) *(f32x4*)(xw + 4 * lane + 256 * j) = v[j];
        }
#pragma unroll
        for (int j = 0; j < 4; ++j) s += (v[j].x * v[j].x + v[j].y * v[j].y) + (v[j].z * v[j].z + v[j].w * v[j].w);
        const float rs = rsqrtf(wave_sum(s) * (1.f / DM) + EPSF);
#pragma unroll
        for (int j = 0; j < 4; ++j) {
            const f32x4 scv = *(const f32x4*)(sc + 4 * lane + 256 * j), shv = *(const f32x4*)(sh + 4 * lane + 256 * j);
            const f32x4 y = v[j] * rs * gv[j] * (scv + 1.f) + shv;
            u32x2 o; o.x = pk2(y.x, y.y); o.y = pk2(y.z, y.w);
            *(u32x2*)(XN + (size_t)row * DM + 4 * lane + 256 * j) = o;
        }
    }
}
__device__ __forceinline__ void final_norm_phase(ArgsP a, int wave, int lane) {
    const int gw = blockIdx.x * NWAVES + wave, NGW = gridDim.x * NWAVES;
    const float* g = a->in[I_FINALG];
    for (int row = gw; row < MLAT; row += NGW) {
        float* xr = a->out + (size_t)row * DM;
        f32x4 v[4]; float s = 0.f;
#pragma unroll
        for (int j = 0; j < 4; ++j) { v[j] = *(const f32x4*)(xr + 4 * lane + 256 * j); s += (v[j].x * v[j].x + v[j].y * v[j].y) + (v[j].z * v[j].z + v[j].w * v[j].w); }
        const float rs = rsqrtf(wave_sum(s) * (1.f / DM) + EPSF);
#pragma unroll
        for (int j = 0; j < 4; ++j) *(f32x4*)(xr + 4 * lane + 256 * j) = v[j] * rs * *(const f32x4*)(g + 4 * lane + 256 * j);
    }
}

__device__ __forceinline__ void prologue_phase(ArgsP a, LAS unsigned char* lds, int tid, int wave, int lane) {
    const int gt = blockIdx.x * NTHREADS + tid, NGT = gridDim.x * NTHREADS;
    cf2* T14 = (cf2*)(a->ws + WS_TW14); cf2* T15 = (cf2*)(a->ws + WS_TW15);
    for (int k = gt; k < 16384; k += NGT) { float s, c; sincospif((float)k * (1.0f / 8192.0f), &s, &c); T14[k] = mk2(c, -s); sincospif((float)k * (1.0f / 16384.0f), &s, &c); T15[k] = mk2(c, -s); }
    { const f32x4* src = (const f32x4*)a->in[I_CTX]; f32x4* dst = (f32x4*)(a->ws + WS_XC); for (int i = gt; i < NBATCH * CTXL * DM / 4; i += NGT) dst[i] = src[i]; }
    LAS float* sc = (LAS float*)lds; LAS float* part = sc + 3 * DM;
    for (int i = tid; i < 3 * DM; i += NTHREADS) { const int mi = i >> 10, k = i & 1023; const float c = mi < 2 ? a->in[I_C][mi * DM + k] : a->in[I_CCTX][k]; sc[i] = c / (1.f + expf(-c)); }
    __syncthreads();
    float* MOD = (float*)(a->ws + WS_MOD);
    for (int u = blockIdx.x; u < DEPTH * 36; u += gridDim.x) {
        const int l = u / 36, n = (u % 36) * 256 + (tid & 255), kh = tid >> 8;
        const float* w = a->in[I_WMOD] + ((size_t)l * DM + kh * 512) * NMODV + n;
        float a0 = 0.f, a1 = 0.f, a2 = 0.f;
#pragma unroll 8
        for (int k = 0; k < 512; ++k) { const float wv = w[(size_t)k * NMODV]; a0 += sc[kh * 512 + k] * wv; a1 += sc[DM + kh * 512 + k] * wv; a2 += sc[2 * DM + kh * 512 + k] * wv; }
        if (kh == 1) { part[tid & 255] = a0; part[256 + (tid & 255)] = a1; part[512 + (tid & 255)] = a2; }
        __syncthreads();
        if (kh == 0) { const float b = a->in[I_BMOD][l * NMODV + n];
            MOD[((size_t)l * 3 + 0) * NMODV + n] = a0 + part[tid] + b; MOD[((size_t)l * 3 + 1) * NMODV + n] = a1 + part[256 + tid] + b; MOD[((size_t)l * 3 + 2) * NMODV + n] = a2 + part[512 + tid] + b; }
        __syncthreads();
    }
}

__device__ __forceinline__ void e1_phase(ArgsP a, int l, LAS unsigned char* lds, int tid, int wave, int lane) {
    const int gw = blockIdx.x * NWAVES + wave, NGW = gridDim.x * NWAVES;
    const int gt = blockIdx.x * NTHREADS + tid, NGT = gridDim.x * NTHREADS;
    bf16_t* PB = (bf16_t*)(a->ws + WS_PB); const bf16_t* PA = (const bf16_t*)(a->ws + WS_PA); bf16_t* R = (bf16_t*)(a->ws + WS_R); float* UT = (float*)(a->ws + WS_UT);
    {
        const float* gain = a->in[I_QKGAIN] + l * 128;
        const int p = lane & 31, hw = lane >> 5;
        const float invf = exp2f(-(float)(p & 15) * (13.287712379549449f / 16.f));
        const float g0a = gain[p], g0b = gain[32 + p], g1a = gain[64 + p], g1b = gain[96 + p];
        for (int row = gw; row < MTOT; row += NGW) {
            float cs = 1.f, sn = 0.f;
            if (row < MLAT) { const int t = row & (SEQ - 1); const float pos = (p < 16) ? (float)(t >> 6) : (float)(t & 63); sincosf(pos * invf, &sn, &cs); }
            bf16_t* pr = PB + (size_t)row * PBP;
#pragma unroll
            for (int i = 0; i < 6; ++i) {
                const int hd = 2 * i + hw; const int col = hd < 6 ? 256 + 64 * hd : 768 + 64 * (hd - 6);
                float z1 = bf2f(pr[col + p]), z2 = bf2f(pr[col + 32 + p]);
                if (i >= 3) {
                    float ss = z1 * z1 + z2 * z2;
#pragma unroll
                    for (int o = 1; o < 32; o <<= 1) ss += __shfl_xor(ss, o);
                    const float r = rsqrtf(ss * (1.f / 64.f) + EPSF);
                    z1 *= r * (i >= 5 ? g1a : g0a); z2 *= r * (i >= 5 ? g1b : g0b);
                }
                float o1 = z1 * cs - z2 * sn, o2 = z1 * sn + z2 * cs;
                if (i < 2 || i == 3 || i == 4) { o1 *= QC2; o2 *= QC2; }
                pr[col + p] = (bf16_t)f2bf(o1); pr[col + 32 + p] = (bf16_t)f2bf(o2);
            }
        }
    }
    {
        const float* cw = a->in[I_LRUCW] + (size_t)l * 4 * 256; const float* cb = a->in[I_LRUCB] + (size_t)l * 256;
        for (int idx = gt; idx < MTOT * 32; idx += NGT) {
            const int row = idx >> 5, ch0 = (idx & 31) * 8; const bool lat = row < MLAT; const int pos = lat ? (row & (SEQ - 1)) : ((row - MLAT) & (CTXL - 1)); const int len = lat ? SEQ : CTXL;
            float acc[8];
#pragma unroll
            for (int i = 0; i < 8; ++i) acc[i] = cb[ch0 + i];
#pragma unroll
            for (int k = 0; k < 4; ++k) { const int pp = pos + k - 2; if (pp >= 0 && pp < len) { float v[8]; unpack8(*(const u32x4*)(PA + (size_t)(row + k - 2) * 1024 + 768 + ch0), v);
#pragma unroll
                for (int i = 0; i < 8; ++i) acc[i] += cw[k * 256 + ch0 + i] * v[i]; } }
            *(u32x4*)(R + (size_t)row * 256 + ch0) = pack8(acc);
        }
    }
    {
        const float* cw = a->in[I_HYCW] + (size_t)l * 3 * 768; const float* cb = a->in[I_HYCB] + (size_t)l * 768; float* UC = (float*)(a->ws + WS_UC);
        for (int idx = gt; idx < NBATCH * CTXL * 768; idx += NGT) {
            const int c = idx % 768, bt = idx / 768, t = bt & (CTXL - 1), b = bt >> 8; const size_t row = (size_t)MLAT + bt;
            float acc = cb[c];
#pragma unroll
            for (int k = 0; k < 3; ++k) { const int tt = t + k - 1; if (tt >= 0 && tt < CTXL) acc += cw[k * 768 + c] * bf2f(PA[(row + k - 1) * 1024 + c]); }
            const int p = c >> 8, ch = c & 255;
            UC[((size_t)(p * 2 + b) * 256 + ch) * 256 + t] = acc;
        }
    }
    {
        const float* cw = a->in[I_HYCW] + (size_t)l * 3 * 768; const float* cb = a->in[I_HYCB] + (size_t)l * 768;
        LAS float* T = (LAS float*)lds; const int cgp = tid & 31, tr = tid >> 5;
        for (int u = blockIdx.x; u < 512 * 3; u += gridDim.x) {
            const int tile = u / 3, plane = u % 3, b = tile >> 8, t0 = (tile & 255) * 64; const int cc = plane * 256 + 8 * cgp;
            float wk[3][8], bb[8];
#pragma unroll
            for (int i = 0; i < 8; ++i) { bb[i] = cb[cc + i]; wk[0][i] = cw[cc + i]; wk[1][i] = cw[768 + cc + i]; wk[2][i] = cw[1536 + cc + i]; }
#pragma unroll
            for (int it = 0; it < 4; ++it) {
                const int tl = tr + 16 * it, t = t0 + tl; const size_t row = (size_t)b * SEQ + t;
                float acc[8];
#pragma unroll
                for (int i = 0; i < 8; ++i) acc[i] = bb[i];
#pragma unroll
                for (int k = 0; k < 3; ++k) { const int tt = t + k - 1; if (tt >= 0 && tt < SEQ) { float v[8]; unpack8(*(const u32x4*)(PA + (row + k - 1) * 1024 + cc), v);
#pragma unroll
                    for (int i = 0; i < 8; ++i) acc[i] += wk[k][i] * v[i]; } }
#pragma unroll
                for (int i = 0; i < 8; ++i) T[(8 * cgp + i) * 65 + tl] = acc[i];
            }
            __syncthreads();
            if (plane == 0) { for (int c = wave; c < 256; c += NWAVES) UT[((size_t)b * 256 + c) * SEQ + t0 + lane] = T[c * 65 + lane]; }
            else {
                bf16_t* UTB = (bf16_t*)(UT + (size_t)2 * 256 * SEQ);
                for (int c = wave; c < 256; c += NWAVES) UTB[((size_t)((plane - 1) * 2 + b) * 256 + c) * SEQ + t0 + lane] = (bf16_t)f2bf(T[c * 65 + lane]);
            }
            __syncthreads();
        }
    }
}

__device__ __forceinline__ void e2_phase(ArgsP a, LAS unsigned char* lds, int tid, int wave, int lane) {
    const int gt = blockIdx.x * NTHREADS + tid, NGT = gridDim.x * NTHREADS;
    const bf16_t* PB = (const bf16_t*)(a->ws + WS_PB); const float* UT = (const float*)(a->ws + WS_UT); bf16_t* Y = (bf16_t*)(a->ws + WS_XN); const cf2* AB = (const cf2*)(a->ws + WS_AB);
    LAS float* T = (LAS float*)lds; const int cgp = tid & 31, tr = tid >> 5;
    for (int u = blockIdx.x; u < 512; u += gridDim.x) {
        const int b = u >> 8, t0 = (u & 255) * 64;
        for (int c = wave; c < 256; c += NWAVES) T[c * 65 + lane] = UT[((size_t)b * 256 + c) * SEQ + t0 + lane];
        __syncthreads();
#pragma unroll
        for (int it = 0; it < 4; ++it) { const int tl = tr + 16 * it; float v[8];
#pragma unroll
            for (int i = 0; i < 8; ++i) v[i] = T[(8 * cgp + i) * 65 + tl];
            *(u32x4*)(Y + ((size_t)b * SEQ + t0 + tl) * DM + 8 * cgp) = pack8(v); }
        __syncthreads();
    }
    const float* CAR = (const float*)(a->ws + WS_CAR);
    for (int idx = gt; idx < MTOT * 32; idx += NGT) {
        const int row = idx >> 5, ch0 = (idx & 31) * 8;
        float g[8]; unpack8(*(const u32x4*)(PB + (size_t)row * PBP + ch0), g);
        const unsigned* h0p = (const unsigned*)AB + (size_t)row * 256 + ch0; const unsigned* h1p = (const unsigned*)AB + ((size_t)MTOT + row) * 256 + ch0;
        const u32x4 q0a = *(const u32x4*)h0p, q0b = *(const u32x4*)(h0p + 4), q1a = *(const u32x4*)h1p, q1b = *(const u32x4*)(h1p + 4);
        const unsigned h0[8] = {q0a.x, q0a.y, q0a.z, q0a.w, q0b.x, q0b.y, q0b.z, q0b.w}, h1[8] = {q1a.x, q1a.y, q1a.z, q1a.w, q1b.x, q1b.y, q1b.z, q1b.w};
        int b, p0, p1;
        if (row < MLAT) { b = row >> 14; const int t = row & (SEQ - 1); p0 = CTXL + t; p1 = CTXL + (SEQ - 1 - t); }
        else { b = (row - MLAT) >> 8; const int j = (row - MLAT) & (CTXL - 1); p0 = j; p1 = CTXL - 1 - j; }
        const float* c0 = CAR + ((size_t)((0 * 2 + b) * NCH + p0 / LCH)) * 256 + ch0; const float* c1 = CAR + ((size_t)((1 * 2 + b) * NCH + p1 / LCH)) * 256 + ch0;
        float v[8];
#pragma unroll
        for (int i = 0; i < 8; ++i) { const float x = g[i]; const float uu = 0.7978845608028654f * (x + 0.044715f * x * x * x); const float th = 1.f - 2.f / (__expf(2.f * uu) + 1.f);
            v[i] = 0.5f * x * (1.f + th) * ((bfhi(h0[i]) + bflo(h0[i]) * c0[i]) + (bfhi(h1[i]) + bflo(h1[i]) * c1[i])); }
        *(u32x4*)(Y + (size_t)row * DM + 256 + ch0) = pack8(v);
    }
}
__device__ __forceinline__ cf2 cmul(cf2 a, cf2 b) { return mk2(a.x * b.x - a.y * b.y, a.x * b.y + a.y * b.x); }
__device__ __forceinline__ cf2 cmulc(cf2 a, cf2 b) { return mk2(a.x * b.x + a.y * b.y, a.y * b.x - a.x * b.y); }
constexpr int FN = 16384;
__device__ __forceinline__ void fft_fwd(LAS cf2* C, const cf2* __restrict__ TW, int tid) {
    for (int lh = 13; lh >= 0; --lh) {
        const int h = 1 << lh;
#pragma unroll 4
        for (int i = tid; i < FN / 2; i += NTHREADS) {
            const int j = i & (h - 1), p0 = ((i >> lh) << (lh + 1)) + j, p1 = p0 + h;
            const cf2 x = C[p0], y = C[p1], w = TW[j << (13 - lh)];
            C[p0] = mk2(x.x + y.x, x.y + y.y);
            C[p1] = cmul(mk2(x.x - y.x, x.y - y.y), w);
        }
        __syncthreads();
    }
}
__device__ __forceinline__ void fft_inv(LAS cf2* C, const cf2* __restrict__ TW, int tid) {
    for (int lh = 0; lh <= 13; ++lh) {
        const int h = 1 << lh;
#pragma unroll 4
        for (int i = tid; i < FN / 2; i += NTHREADS) {
            const int j = i & (h - 1), p0 = ((i >> lh) << (lh + 1)) + j, p1 = p0 + h;
            const cf2 x = C[p0], y = cmulc(C[p1], TW[j << (13 - lh)]);
            C[p0] = mk2(x.x + y.x, x.y + y.y);
            C[p1] = mk2(x.x - y.x, x.y - y.y);
        }
        __syncthreads();
    }
}
__device__ __forceinline__ float block_sum(float v, LAS float* red, int tid, int wave, int lane) {
    v = wave_sum(v);
    __syncthreads();
    if (lane == 0) red[wave] = v;
    __syncthreads();
    float t = 0.f;
#pragma unroll
    for (int i = 0; i < NWAVES; ++i) t += red[i];
    return t;
}
constexpr float HY_MIN_DECAY = -3.0701134573253946f, HY_MAX_DECAY = -15.350567286626973f;

constexpr int CPAD = 17920;
#define PH(p) ((p) + ((p) >> 4) + (((p) >> 9) << 4))
struct TwC { float c[9]; };
__device__ __forceinline__ TwC make_twc() {
    TwC t; t.c[0] = 1.f; t.c[1] = 0.980785280f; t.c[2] = 0.923879533f; t.c[3] = 0.831469612f; t.c[4] = 0.707106781f; t.c[5] = 0.555570233f; t.c[6] = 0.382683432f; t.c[7] = 0.195090322f; t.c[8] = 0.f;
#pragma unroll
    for (int k = 1; k < 8; ++k) asm volatile("" : "+v"(t.c[k]));
    return t;
}
#define TWC_COS(W, m) ((m) <= 8 ? (W).c[(m)] : -(W).c[16 - (m)])
#define TWC_SIN(W, m) ((m) <= 8 ? (W).c[8 - (m)] : (W).c[(m) - 8])
template <int R, bool HASB> __device__ __forceinline__ void dif_regs(cf2 (&x)[R], const TwC& W, const cf2 (&B)[5]) {
    constexpr int LOGR = (R == 32) ? 5 : 4;
#pragma unroll
    for (int st = 0; st < LOGR; ++st) {
        const int d = (R / 2) >> st;
#pragma unroll
        for (int i = 0; i < R; ++i) if ((i & d) == 0) {
            const int m = (i & (d - 1)) * (16 / d);
            const cf2 a = x[i], b = x[i + d];
            x[i] = mk2(a.x + b.x, a.y + b.y); float tx = a.x - b.x, ty = a.y - b.y;
            if (m == 8) { const float u = tx; tx = ty; ty = -u; }
            else if (m != 0) { const float c = TWC_COS(W, m), s = TWC_SIN(W, m); const float u = tx * c + ty * s; ty = ty * c - tx * s; tx = u; }
            if (HASB) { const float u = tx * B[st].x - ty * B[st].y; ty = tx * B[st].y + ty * B[st].x; tx = u; }
            x[i + d] = mk2(tx, ty);
        }
        __builtin_amdgcn_sched_barrier(0);
    }
}
template <int R, bool HASB> __device__ __forceinline__ void dit_regs(cf2 (&x)[R], const TwC& W, const cf2 (&B)[5]) {
    constexpr int LOGR = (R == 32) ? 5 : 4;
#pragma unroll
    for (int st = LOGR - 1; st >= 0; --st) {
        const int d = (R / 2) >> st;
#pragma unroll
        for (int i = 0; i < R; ++i) if ((i & d) == 0) {
            const int m = (i & (d - 1)) * (16 / d);
            const cf2 a = x[i], b = x[i + d]; float bx = b.x, by = b.y;
            if (HASB) { const float u = bx * B[st].x + by * B[st].y; by = by * B[st].x - bx * B[st].y; bx = u; }
            if (m == 8) { const float u = bx; bx = -by; by = u; }
            else if (m != 0) { const float c = TWC_COS(W, m), s = TWC_SIN(W, m); const float u = bx * c - by * s; by = by * c + bx * s; bx = u; }
            x[i] = mk2(a.x + bx, a.y + by); x[i + d] = mk2(a.x - bx, a.y - by);
        }
        __builtin_amdgcn_sched_barrier(0);
    }
}
struct FftCtx { LAS cf2* C; const cf2* T14; int tid; };
template <bool INV> __device__ __forceinline__ void pass1(const FftCtx& F_) {
    FftCtx F = F_; asm volatile("" : "+v"(F.tid)); const TwC W = make_twc();
    cf2 x[32], B[5];
#pragma unroll
    for (int s = 0; s < 5; ++s) B[s] = F.T14[F.tid << s];
#pragma unroll
    for (int i = 0; i < 32; ++i) x[i] = F.C[PH(512 * i + F.tid)];
    __builtin_amdgcn_sched_barrier(0);
    if (INV) dit_regs<32, true>(x, W, B); else dif_regs<32, true>(x, W, B);
#pragma unroll
    for (int i = 0; i < 32; ++i) F.C[PH(512 * i + F.tid)] = x[i];
}
template <bool INV> __device__ __forceinline__ void pass2(const FftCtx& F_) {
    FftCtx F = F_; asm volatile("" : "+v"(F.tid)); const TwC W = make_twc();
    const int blk = F.tid >> 4, q = F.tid & 15;
    cf2 x[32], B[5];
#pragma unroll
    for (int s = 0; s < 5; ++s) B[s] = F.T14[q << (5 + s)];
#pragma unroll
    for (int i = 0; i < 32; ++i) x[i] = F.C[PH(512 * blk + q + 16 * i)];
    __builtin_amdgcn_sched_barrier(0);
    if (INV) dit_regs<32, true>(x, W, B); else dif_regs<32, true>(x, W, B);
#pragma unroll
    for (int i = 0; i < 32; ++i) F.C[PH(512 * blk + q + 16 * i)] = x[i];
}
template <int MODE> __device__ __forceinline__ void pass3(const FftCtx& F_, cf2* K) {
    FftCtx F = F_; asm volatile("" : "+v"(F.tid)); const TwC W = make_twc();
    cf2 B[5];
#pragma unroll
    for (int s = 0; s < 5; ++s) B[s] = mk2(1.f, 0.f);
#pragma unroll
    for (int g = 0; g < 2; ++g) {
        const int base = 16 * (F.tid + 512 * g); cf2 y[16];
#pragma unroll
        for (int i = 0; i < 16; ++i) y[i] = F.C[PH(base + i)];
        __builtin_amdgcn_sched_barrier(0);
        dif_regs<16, false>(y, W, B);
        if (MODE == 0) {
#pragma unroll
            for (int r = 0; r < 16; ++r) (K + (g * 16 + r) * 512)[F.tid] = y[r];
        } else {
#pragma unroll
            for (int r = 0; r < 16; ++r) { y[r] = cmul(y[r], (K + (g * 16 + r) * 512)[F.tid]); if ((r & 7) == 7) __builtin_amdgcn_sched_barrier(0); }
            dit_regs<16, false>(y, W, B);
#pragma unroll
            for (int i = 0; i < 16; ++i) F.C[PH(base + i)] = y[i];
        }
        __builtin_amdgcn_sched_barrier(0);
    }
}
__device__ __forceinline__ void fft_to_spectrum(const FftCtx& F, cf2* K) {
    pass1<false>(F); __syncthreads(); pass2<false>(F); __syncthreads(); pass3<0>(F, K); __syncthreads();
}
__device__ __forceinline__ void fft_conv(const FftCtx& F, cf2* K) {
    pass1<false>(F); __syncthreads(); pass2<false>(F); __syncthreads(); pass3<1>(F, K); __syncthreads(); pass2<true>(F); __syncthreads(); pass1<true>(F); __syncthreads();
}

#define LTID int tl = tid; asm volatile("" : "+v"(tl));
__device__ __forceinline__ void hyena_unit2(ArgsP a, int l, int ch, LAS unsigned char* lds, int tid, int wave, int lane, const int DRY) {
    LAS cf2* C = (LAS cf2*)lds;
    LAS float* red = (LAS float*)(lds + CPAD * 8); LAS float* wcol = red + 16;
    const cf2* T15 = (const cf2*)(a->ws + WS_TW15);
    FftCtx F; F.C = C; F.T14 = (const cf2*)(a->ws + WS_TW14); F.tid = tid;
    const float* H2T = (const float*)(a->ws + WS_H2);
    cf2* KE = (cf2*)(a->ws + WS_KF + (size_t)blockIdx.x * 262144); cf2* KO = KE + FN;
    float* UT = (float*)(a->ws + WS_UT);
    float* v0 = UT + ((size_t)(0 * 2 + 0) * 256 + ch) * SEQ; float* v1 = UT + ((size_t)(0 * 2 + 1) * 256 + ch) * SEQ;
    const float delta = fabsf(HY_MIN_DECAY + (float)ch * ((HY_MAX_DECAY - HY_MIN_DECAY) / 255.0f));
#pragma unroll 1
    for (int o = 0; o < 2; ++o) {
        const float* w3 = a->in[I_HYW3] + (size_t)l * 64 * 1024 + o * 512 + ch;
        __syncthreads();
        { LTID if (tl < 128) wcol[tl] = w3[(size_t)(tl & 63) * 1024 + (tl >> 6) * 256]; }
        __syncthreads();
        float asum = 0.f;
        {   LTID const LAS f32x4* wc4 = (const LAS f32x4*)wcol; asm volatile("" : "+v"(wc4));
#pragma unroll 1
            for (int i0 = 0; i0 < 32; i0 += 4) {
                const float* hc = H2T + tl + NTHREADS * i0;
                float f[4] = {0.f, 0.f, 0.f, 0.f}, bk[4] = {0.f, 0.f, 0.f, 0.f};
#pragma unroll
                for (int j4 = 0; j4 < 16; ++j4) {
                    const f32x4 wf = wc4[j4], wb = wc4[16 + j4];
#pragma unroll
                    for (int jj = 0; jj < 4; ++jj) {
#pragma unroll
                        for (int e = 0; e < 4; ++e) { const float hv = hc[(size_t)(4 * j4 + jj) * SEQ + NTHREADS * e]; f[e] += hv * wf[jj]; bk[e] += hv * wb[jj]; }
                    }
                }
#pragma unroll
                for (int e = 0; e < 4; ++e) {
                    const int t = tl + NTHREADS * (i0 + e);
                    const float dec = expf(-((float)t * (1.0f / (float)(SEQ - 1))) * delta);
                    const float fv = f[e] * dec, bv = bk[e] * dec; asum += fabsf(fv) + fabsf(bv);
                    C[PH(t)] = mk2(fv, bv);
                }
            }
        }
        const float tot = block_sum(asum, red, tid, wave, lane);
        const float scale = 1.0f / ((tot + EPSF) * (float)(2 * FN));
        { LTID
#pragma unroll 8
        for (int i = 0; i < 32; ++i) {
            const int t = tl + NTHREADS * i;
            const float fw = C[PH(t)].x, bw = (t > 0) ? C[PH(FN - t)].y : 0.f;
            const float d = (fw - bw) * scale; const cf2 w = T15[t];
            KE[t] = mk2((fw + bw) * scale, 0.f); KO[t] = mk2(d * w.x, d * w.y);
        } }
        __syncthreads();
        { LTID
#pragma unroll 16
        for (int i = 0; i < 32; ++i) { const int t = tl + NTHREADS * i; C[PH(t)] = KE[t]; } }
        __syncthreads();
        fft_to_spectrum(F, KE);
        { LTID
#pragma unroll 16
        for (int i = 0; i < 32; ++i) { const int t = tl + NTHREADS * i; C[PH(t)] = KO[t]; } }
        __syncthreads();
        fft_to_spectrum(F, KO);
        { LTID
#pragma unroll 16
        for (int i = 0; i < 32; ++i) { const int t = tl + NTHREADS * i; C[PH(t)] = mk2(v0[t], v1[t]); } }
        __syncthreads();
        fft_conv(F, KE);
        { LTID
#pragma unroll 16
        for (int i = 0; i < 32; ++i) { const int t = tl + NTHREADS * i; KE[t] = C[PH(t)]; } }
        __syncthreads();
        { LTID
#pragma unroll 8
        for (int i = 0; i < 32; ++i) { const int t = tl + NTHREADS * i; C[PH(t)] = cmul(mk2(v0[t], v1[t]), T15[t]); } }
        __syncthreads();
        fft_conv(F, KO);
        const float sk = a->in[I_HYSKIP][((size_t)l * 2 + o) * 256 + ch];
        const bf16_t* UTB = (const bf16_t*)(UT + (size_t)2 * 256 * SEQ);
        const bf16_t* m0 = UTB + ((size_t)(o * 2 + 0) * 256 + ch) * SEQ; const bf16_t* m1 = UTB + ((size_t)(o * 2 + 1) * 256 + ch) * SEQ;
        { LTID
#pragma unroll 8
        for (int i = 0; i < 32; ++i) {
            const int t = tl + NTHREADS * i;
            const cf2 bq = cmulc(C[PH(t)], T15[t]); const cf2 av = KE[t];
            const float x0 = v0[t], x1 = v1[t];
            const float y0 = av.x + bq.x + sk * x0, y1 = av.y + bq.y + sk * x1;
            v0[t] = bf2f(m0[t]) * y0; v1[t] = bf2f(m1[t]) * y1;
        } }
        __syncthreads();
    }
}

__device__ __forceinline__ void hyena_ctx_unit(ArgsP a, int l, int ch, LAS unsigned char* lds, int tid, int wave, int lane) {
    LAS float* F = (LAS float*)lds;
    LAS float* U = F + 1024;
    LAS float* Z = U + 1536;
    LAS float* red = Z + 512;
    const float* H2C = (const float*)(a->ws + WS_H2C); bf16_t* Y = (bf16_t*)(a->ws + WS_XN);
    const float delta = fabsf(HY_MIN_DECAY + (float)ch * ((HY_MAX_DECAY - HY_MIN_DECAY) / 255.0f));
    __syncthreads();
    {
        const int o = tid >> 8, t = tid & 255; const float* w3 = a->in[I_HYW3] + (size_t)l * 64 * 1024 + o * 512 + ch; const float* hr = H2C + t * 64;
        float f = 0.f, bk = 0.f;
#pragma unroll 8
        for (int j = 0; j < 64; ++j) { const float hv = hr[j]; f += hv * w3[(size_t)j * 1024]; bk += hv * w3[(size_t)j * 1024 + 256]; }
        const float dec = expf(-((float)t * (1.0f / 255.0f)) * delta); f *= dec; bk *= dec;
        float s = wave_sum(fabsf(f) + fabsf(bk));
        if (lane == 0) red[wave] = s;
        __syncthreads();
        const float tot = (red[4 * o] + red[4 * o + 1]) + (red[4 * o + 2] + red[4 * o + 3]);
        const float sc = 1.f / (tot + EPSF);
        F[(o * 2 + 0) * 256 + t] = f * sc; F[(o * 2 + 1) * 256 + t] = bk * sc;
    }
    {
        const int b = tid >> 8, t = tid & 255; const float* UC = (const float*)(a->ws + WS_UC);
#pragma unroll
        for (int p = 0; p < 3; ++p) U[(p * 2 + b) * 256 + t] = UC[((size_t)(p * 2 + b) * 256 + ch) * 256 + t];
    }
    __syncthreads();
    const int b = tid >> 8, t = tid & 255;
    {
        const LAS float* fw = F, *bw = F + 256; const LAS float* x = U + b * 256; float y = 0.f;
        for (int s = 0; s <= t; ++s) y += fw[t - s] * x[s];
        for (int s = t + 1; s < CTXL; ++s) y += bw[s - t] * x[s];
        y += a->in[I_HYSKIP][((size_t)l * 2 + 0) * 256 + ch] * x[t];
        Z[b * 256 + t] = U[(2 + b) * 256 + t] * y;
    }
    __syncthreads();
    {
        const LAS float* fw = F + 512, *bw = F + 768; const LAS float* x = Z + b * 256; float y = 0.f;
        for (int s = 0; s <= t; ++s) y += fw[t - s] * x[s];
        for (int s = t + 1; s < CTXL; ++s) y += bw[s - t] * x[s];
        y += a->in[I_HYSKIP][((size_t)l * 2 + 1) * 256 + ch] * x[t];
        Y[((size_t)MLAT + b * CTXL + t) * DM + ch] = (bf16_t)f2bf(U[(4 + b) * 256 + t] * y);
    }
    __syncthreads();
}

#define MIX_TID int tid = threadIdx.x; asm volatile("" : "+v"(tid)); const int lane = tid & 63, wave = __builtin_amdgcn_readfirstlane(tid >> 6); (void)lane; (void)wave;
__device__ __forceinline__ void mix_phase(int l, LAS unsigned char* lds, char* lds_generic) {
    using attn_body::AttnJob; typedef attn_body::bf16 abf;
    const int G = gridDim.x, bx = blockIdx.x;
#ifndef NO_HY
    for (int u = bx; u < 256; u += G) { MIX_TID ArgsP a = args_ptr();
#ifdef PROBE_HY
#pragma unroll 1
        for (int rep = 1; rep >= 0; --rep)
#else
        const int rep = 0;
#endif
        hyena_unit2(a, l, u, lds, tid, wave, lane, rep); }
#endif
#ifndef NO_LRU
    for (int u = bx - 128; u >= 0 && u < 4; u += G) { MIX_TID ArgsP a = args_ptr(); lru_carry_unit(a, u, tid); }
#endif
#ifndef NO_ATT
    for (int v = bx; v < 512; v += G) {
        ArgsP a = args_ptr(); const abf* PB = (const abf*)(a->ws + WS_PB); abf* Y = (abf*)(a->ws + WS_XN);
        const int xcd = v & 7, ii = (v & 255) >> 3, rr = v >> 8, uu = 2 * ii + rr;
        const int b = xcd >> 2, kvh = (xcd >> 1) & 1, h = 2 * kvh + (uu & 1), qb = (uu >> 1) * 2 + (xcd & 1);
        AttnJob J; J.Q = PB + 768 + 64 * h; J.K = PB + 1024 + 64 * (h >> 1); J.V = PB + 1152 + 64 * (h >> 1); J.O = Y + 768 + 64 * h;
        J.qrow0 = b * SEQ + qb * 256; J.ctxrow0 = MLAT + b * CTXL; J.bandrow0 = b * SEQ; J.NT = 4 + SEQ / 64; J.qpos0 = qb * 256; J.kpos0 = 0; J.sink2 = 0.f; J.has_sink = 0;
        attn_body::attn_unit<8, false>(J, lds_generic);
#ifdef PROBE_ATT
        attn_body::attn_unit<8, false>(J, lds_generic);
#endif
    }
    for (int v = bx; v < 512; v += G) {
        ArgsP a = args_ptr(); const abf* PB = (const abf*)(a->ws + WS_PB); abf* Y = (abf*)(a->ws + WS_XN);
        const int qb = v & 63, h = (v >> 6) & 3, b = v >> 8;
        const int k0 = (qb == 0) ? 0 : qb * 256 - 128, k1 = (qb == 63) ? SEQ : qb * 256 + 384;
        AttnJob J; J.Q = PB + 256 + 64 * h; J.K = PB + 512 + 64 * (h >> 1); J.V = PB + 640 + 64 * (h >> 1); J.O = Y + 512 + 64 * h;
        J.qrow0 = b * SEQ + qb * 256; J.ctxrow0 = MLAT + b * CTXL; J.bandrow0 = b * SEQ + k0; J.NT = 4 + (k1 - k0) / 64; J.qpos0 = qb * 256; J.kpos0 = k0;
        J.sink2 = a->in[I_SINK][l * 4 + h] * LOG2E; J.has_sink = 1;
        attn_body::attn_unit<8, true>(J, lds_generic);
    }
    if (l + 1 < DEPTH)
    for (int v = bx - 64; v >= 0 && v < 16; v += G) {
        ArgsP a = args_ptr(); const abf* PB = (const abf*)(a->ws + WS_PB); abf* Y = (abf*)(a->ws + WS_XN);
        const int h = v & 3, b = (v >> 2) & 1, glb = v >> 3;
        AttnJob J; J.Q = PB + (glb ? 768 : 256) + 64 * h; J.K = PB + (glb ? 1024 : 512) + 64 * (h >> 1); J.V = PB + (glb ? 1152 : 640) + 64 * (h >> 1); J.O = Y + (glb ? 768 : 512) + 64 * h;
        J.qrow0 = MLAT + b * CTXL; J.ctxrow0 = MLAT + b * CTXL; J.bandrow0 = 0; J.NT = 4; J.qpos0 = 0; J.kpos0 = 0;
        J.sink2 = glb ? 0.f : a->in[I_SINK][l * 4 + h] * LOG2E; J.has_sink = glb ? 0 : 1;
        attn_body::attn_unit<8, false>(J, lds_generic);
    }
#endif
#ifndef NO_CHY
    if (l + 1 < DEPTH)
    for (int u = bx; u < 256; u += G) { MIX_TID ArgsP a = args_ptr(); hyena_ctx_unit(a, l, u, lds, tid, wave, lane); }
#endif
}

#ifdef NO_GEMM
#define GEMM_CALL if (0)
#else
#define GEMM_CALL
#endif
#define LAUNDER_TID int tid = threadIdx.x; asm volatile("" : "+v"(tid)); const int lane = tid & 63, wave = __builtin_amdgcn_readfirstlane(tid >> 6); (void)lane; (void)wave;
template <int l> __device__ __forceinline__ void layer_body(const XcdBarrier& bar, LAS unsigned char* lds, char* lds_generic) {

        {   ArgsP a = args_ptr(); unsigned char* ws = a->ws; bf16_t* XN = (bf16_t*)(ws + WS_XN); bf16_t* Hb = (bf16_t*)(ws + WS_H); float* XC = (float*)(ws + WS_XC); const float* MOD = (const float*)(ws + WS_MOD) + (size_t)l * 3 * NMODV; (void)XN; (void)Hb; (void)XC; (void)MOD;
            pg8::Gemm g{XN, (const bf16_t*)(ws + WS_W13A), MTOT, 2 * DFF, DM, DM, (2 * DFF) / 256}; pg8::StaticOrder S; S.init(MTOT, 2 * DFF, gridDim.x, blockIdx.x);
            EpiSwiGLU E{Hb}; GEMM_CALL pg8::gemm_phase<EpiSwiGLU, pg8::StaticOrder, true, true>(lds, g, S, E);
        }
        xcd_barrier(bar);
        {   ArgsP a = args_ptr(); unsigned char* ws = a->ws; bf16_t* XN = (bf16_t*)(ws + WS_XN); bf16_t* Hb = (bf16_t*)(ws + WS_H); float* XC = (float*)(ws + WS_XC); const float* MOD = (const float*)(ws + WS_MOD) + (size_t)l * 3 * NMODV; (void)XN; (void)Hb; (void)XC; (void)MOD;
            pg8::Gemm g{Hb, (const bf16_t*)(ws + WS_W2A), MLAT, DM, DFF, DFF, (DM) / 256}; pg8::StaticOrder S; S.init(MLAT, DM, gridDim.x, blockIdx.x);
            EpiResid E{a->out, XC, MOD + 2 * DM, 0.5f, (l == 0) ? a->in[I_X] : (const float*)a->out}; GEMM_CALL pg8::gemm_phase<EpiResid, pg8::StaticOrder, true, true>(lds, g, S, E);
            { pg8::Gemm gc{Hb + (size_t)MLAT * DFF, (const bf16_t*)(ws + WS_W2A), NBATCH * CTXL, DM, DFF, DFF / 11, DM / 256}; pg8::StaticOrder Sc; Sc.init(NBATCH * CTXL, DM * 11, gridDim.x, blockIdx.x);
              EpiResidCtxSplitK Ec{(float*)(ws + WS_PART), MOD + 2 * DM, 0.5f, DM / 256}; GEMM_CALL pg8::gemm_phase<EpiResidCtxSplitK, pg8::StaticOrder, true, true>(lds, gc, Sc, Ec); }
        }
        xcd_barrier(bar);
        { LAUNDER_TID ArgsP a = args_ptr(); norm_phase(a, l, 1, wave, lane, 11); }
        xcd_barrier(bar);
        {   ArgsP a = args_ptr(); unsigned char* ws = a->ws; bf16_t* XN = (bf16_t*)(ws + WS_XN); bf16_t* Hb = (bf16_t*)(ws + WS_H); float* XC = (float*)(ws + WS_XC); const float* MOD = (const float*)(ws + WS_MOD) + (size_t)l * 3 * NMODV; (void)XN; (void)Hb; (void)XC; (void)MOD;
            pg8::Gemm g{XN, (const bf16_t*)(ws + WS_WIN), MTOT, DIN, DM, DM, (DIN) / 256}; pg8::StaticOrder S; S.init(MTOT, DIN, gridDim.x, blockIdx.x);
            EpiProj E{(bf16_t*)(ws + WS_PA), (bf16_t*)(ws + WS_PB)}; GEMM_CALL pg8::gemm_phase<EpiProj, pg8::StaticOrder, true, true>(lds, g, S, E);
        }
        xcd_barrier(bar);
#ifndef NO_E1
        { LAUNDER_TID ArgsP a = args_ptr(); e1_phase(a, l, lds, tid, wave, lane); }
#endif
        xcd_barrier(bar);
        {   ArgsP a = args_ptr(); unsigned char* ws = a->ws; bf16_t* XN = (bf16_t*)(ws + WS_XN); bf16_t* Hb = (bf16_t*)(ws + WS_H); float* XC = (float*)(ws + WS_XC); const float* MOD = (const float*)(ws + WS_MOD) + (size_t)l * 3 * NMODV; (void)XN; (void)Hb; (void)XC; (void)MOD;
            pg8::Gemm g{(const bf16_t*)(ws + WS_R), (const bf16_t*)(ws + WS_WLRU), MTOT, 1024, 256, 256, (1024) / 256}; pg8::StaticOrder S; S.init(MTOT, 1024, gridDim.x, blockIdx.x);
            EpiLru E{(unsigned*)(ws + WS_RAW0), (unsigned*)(ws + WS_RAW1)};
            GEMM_CALL pg8::gemm_phase<EpiLru, pg8::StaticOrder, true, true>(lds, g, S, E);
        }
        xcd_barrier(bar);
        { LAUNDER_TID ArgsP a = args_ptr(); lru_gate_phase(a, l, tid); }
        xcd_barrier(bar);
        mix_phase(l, lds, lds_generic);
        xcd_barrier(bar);
        { LAUNDER_TID ArgsP a = args_ptr(); e2_phase(a, lds, tid, wave, lane); }
        xcd_barrier(bar);
        {   ArgsP a = args_ptr(); unsigned char* ws = a->ws; bf16_t* XN = (bf16_t*)(ws + WS_XN); bf16_t* Hb = (bf16_t*)(ws + WS_H); float* XC = (float*)(ws + WS_XC); const float* MOD = (const float*)(ws + WS_MOD) + (size_t)l * 3 * NMODV; (void)XN; (void)Hb; (void)XC; (void)MOD;
            pg8::Gemm g{XN, (const bf16_t*)(ws + WS_WOUT), MLAT, DM, DM, DM, (DM) / 256}; pg8::StaticOrder S; S.init(MLAT, DM, gridDim.x, blockIdx.x);
            EpiResid E{a->out, XC, MOD + 5 * DM, 1.0f, a->out}; GEMM_CALL pg8::gemm_phase<EpiResid, pg8::StaticOrder, true, true>(lds, g, S, E);
            if (l + 1 < DEPTH) { pg8::Gemm gc{XN + (size_t)MLAT * DM, (const bf16_t*)(ws + WS_WOUT), NBATCH * CTXL, DM, DM, DM / 4, DM / 256}; pg8::StaticOrder Sc; Sc.init(NBATCH * CTXL, DM * 4, gridDim.x, blockIdx.x);
              EpiResidCtxSplitK Ec{(float*)(ws + WS_PART), MOD + 5 * DM, 1.0f, DM / 256}; GEMM_CALL pg8::gemm_phase<EpiResidCtxSplitK, pg8::StaticOrder, true, true>(lds, gc, Sc, Ec); }
        }
        xcd_barrier(bar);
        { LAUNDER_TID ArgsP a = args_ptr(); norm_phase(a, l, 2, wave, lane, (l + 1 < DEPTH) ? 4 : 0); }
        xcd_barrier(bar);
        {   ArgsP a = args_ptr(); unsigned char* ws = a->ws; bf16_t* XN = (bf16_t*)(ws + WS_XN); bf16_t* Hb = (bf16_t*)(ws + WS_H); float* XC = (float*)(ws + WS_XC); const float* MOD = (const float*)(ws + WS_MOD) + (size_t)l * 3 * NMODV; (void)XN; (void)Hb; (void)XC; (void)MOD;
            constexpr int M5 = (l + 1 < DEPTH) ? MTOT : MLAT;
            pg8::Gemm g{XN, (const bf16_t*)(ws + WS_W13B), M5, 2 * DFF, DM, DM, (2 * DFF) / 256}; pg8::StaticOrder S; S.init(M5, 2 * DFF, gridDim.x, blockIdx.x);
            EpiSwiGLU E{Hb}; GEMM_CALL pg8::gemm_phase<EpiSwiGLU, pg8::StaticOrder, true, true>(lds, g, S, E);
        }
        xcd_barrier(bar);
        {   ArgsP a = args_ptr(); unsigned char* ws = a->ws; bf16_t* XN = (bf16_t*)(ws + WS_XN); bf16_t* Hb = (bf16_t*)(ws + WS_H); float* XC = (float*)(ws + WS_XC); const float* MOD = (const float*)(ws + WS_MOD) + (size_t)l * 3 * NMODV; (void)XN; (void)Hb; (void)XC; (void)MOD;
            pg8::Gemm g{Hb, (const bf16_t*)(ws + WS_W2B), MLAT, DM, DFF, DFF, (DM) / 256}; pg8::StaticOrder S; S.init(MLAT, DM, gridDim.x, blockIdx.x);
            EpiResid E{a->out, XC, MOD + 8 * DM, 0.5f, a->out}; GEMM_CALL pg8::gemm_phase<EpiResid, pg8::StaticOrder, true, true>(lds, g, S, E);
            if (l + 1 < DEPTH) { pg8::Gemm gc{Hb + (size_t)MLAT * DFF, (const bf16_t*)(ws + WS_W2B), NBATCH * CTXL, DM, DFF, DFF / 11, DM / 256}; pg8::StaticOrder Sc; Sc.init(NBATCH * CTXL, DM * 11, gridDim.x, blockIdx.x);
              EpiResidCtxSplitK Ec{(float*)(ws + WS_PART), MOD + 8 * DM, 0.5f, DM / 256}; GEMM_CALL pg8::gemm_phase<EpiResidCtxSplitK, pg8::StaticOrder, true, true>(lds, gc, Sc, Ec); }
        }
        xcd_barrier(bar);
        if (l + 1 < DEPTH) { LAUNDER_TID ArgsP a = args_ptr(); prep_layer(a, l + 1, lds, tid, wave, lane); norm_phase(a, l + 1, 0, wave, lane, 11); xcd_barrier(bar); }
    }

__global__ void __launch_bounds__(NTHREADS, 2) fwd_megakernel(Args a_byvalue) {
    extern __shared__ __attribute__((aligned(16))) unsigned char lds_raw[];
    cg::grid_group grid = cg::this_grid();
    LAS unsigned char* lds = (LAS unsigned char*)lds_raw;
    volatile LAS unsigned* bst = (volatile LAS unsigned*)(lds + LDS_BYTES - 64);
    if (threadIdx.x < 16) bst[threadIdx.x] = 0u;
    __syncthreads();
    XcdBarrier bar = xcd_barrier_post((unsigned*)args_ptr()->ws, bst);

    { LAUNDER_TID ArgsP a = args_ptr();
#ifndef NO_PRO
    prologue_phase(a, lds, tid, wave, lane);
    prep_layer(a, 0, lds, tid, wave, lane);
#endif
    grid.sync();
    norm_phase(a, 0, 0, wave, lane, 0, true); }
    xcd_barrier(bar);
    layer_body<0>(bar, lds, (char*)lds_raw);
    layer_body<1>(bar, lds, (char*)lds_raw);
    layer_body<2>(bar, lds, (char*)lds_raw);
    layer_body<3>(bar, lds, (char*)lds_raw);
    { LAUNDER_TID ArgsP a = args_ptr(); final_norm_phase(a, wave, lane); }
}

extern "C" void kernel_launch(void* const* d_in, const int* in_sizes, int n_in, void* d_out, int out_size, void* d_ws, size_t ws_size, hipStream_t stream) {
    static int grid_blocks = 0;
    if (grid_blocks == 0) {
        if (n_in != 32 || out_size != MLAT * DM || ws_size < WS_END) { fprintf(stderr, "kernel_launch: unexpected problem: n_in %d out %d ws %zu (need %zu)\n", n_in, out_size, ws_size, (size_t)WS_END); grid_blocks = -1; return; }
        int dev = 0, cus = 0, per_cu = 0;
        hipGetDevice(&dev); hipDeviceGetAttribute(&cus, hipDeviceAttributeMultiprocessorCount, dev);
        hipFuncSetAttribute((const void*)fwd_megakernel, hipFuncAttributeMaxDynamicSharedMemorySize, LDS_BYTES);
        hipOccupancyMaxActiveBlocksPerMultiprocessor(&per_cu, (const void*)fwd_megakernel, NTHREADS, LDS_BYTES);
        if (per_cu < 1) { fprintf(stderr, "kernel_launch: occupancy query says %d blocks per CU\n", per_cu); per_cu = 1; }
        (void)hipGetLastError();
        grid_blocks = cus * per_cu;
    }
    if (grid_blocks < 0) return;
    Args a{};
    for (int i = 0; i < 32; ++i) a.in[i] = (const float*)d_in[i];
    a.out = (float*)d_out; a.ws = (unsigned char*)d_ws;
    (void)hipMemsetAsync(d_ws, 0, 16384, stream);
    void* args[] = {&a};
    hipError_t e = hipLaunchCooperativeKernel((const void*)fwd_megakernel, dim3(grid_blocks), dim3(NTHREADS), args, LDS_BYTES, stream);
    if (e != hipSuccess) fprintf(stderr, "cooperative launch failed: %s (grid %d)\n", hipGetErrorString(e), grid_blocks);
}
```

```cpp
#include <hip/hip_runtime.h>
#include <hip/hip_cooperative_groups.h>
#include <hip/hip_bf16.h>
#include <cstdio>
#include <cstdint>
#include <cmath>
namespace cg = cooperative_groups;
namespace pg8 {
#define PG8_LAS __attribute__((address_space(3)))
typedef unsigned short bf16_t;
typedef short bf16x8 __attribute__((ext_vector_type(8)));
typedef float f32x4 __attribute__((ext_vector_type(4)));
typedef unsigned u32x4 __attribute__((ext_vector_type(4)));
constexpr int BM = 256, BK = 64, HALF = 128, HTB = HALF * BK * 2  , STAGE_BYTES = 8 * HTB, NXCD = 8, WGM = 8;

__host__ __device__ __forceinline__ int lds_byte(int r, int c) { const int st = (r >> 4) * 2 + (c >> 5), rr = r & 15, cc = c & 31, ob = rr * 64 + cc * 2; return st * 1024 + (ob ^ (((ob >> 9) & 1) << 5)); }
__host__ __device__ __forceinline__ void stage_rc(int b, int& R, int& C) { const int st = b / 1024, sb = b % 1024, swz = sb ^ (((sb >> 9) & 1) << 5); R = (st >> 1) * 16 + swz / 64; C = (st & 1) * 32 + (swz % 64) / 2; }
__host__ __device__ __forceinline__ int perm32(int rho) { const int n = rho >> 4, i = rho & 15; return 8 * (i >> 2) + 4 * n + (i & 3); }

struct Unit { int pm, pn; };
struct Gemm { const bf16_t* A; const bf16_t* Bt; int M, N, K; int KL, nNr; };

struct StaticOrder {
    int nM, nN, nwg, G, c;
    __host__ __device__ void init(int M, int N, int G_, int c_) { nM = M / BM; nN = N / BM; nwg = nM * nN; G = G_; c = c_; }
    __host__ __device__ bool next(int i, Unit& u) const {
        const long L = (long)i * G + c; if (L >= nwg) return false;
        int wgid = (int)L; { const int q = nwg / NXCD, r = nwg % NXCD, xcd = wgid % NXCD, off = wgid / NXCD; wgid = (xcd < r ? xcd * (q + 1) : r * (q + 1) + (xcd - r) * q) + off; }
        const int nig = WGM * nN, gid = wgid / nig, fm = gid * WGM, gsz = (nM - fm) < WGM ? (nM - fm) : WGM;
        u.pm = fm + ((wgid % nig) % gsz); u.pn = (wgid % nig) / gsz; return true;
    }
    __device__ __forceinline__ void a_ready(const Unit&) const {}
    __device__ __forceinline__ void done(const Unit&) const {}
};

__device__ __forceinline__ unsigned cvt_pk_bf16(float lo, float hi) { unsigned r; asm volatile("v_cvt_pk_bf16_f32 %0, %1, %2" : "=v"(r) : "v"(lo), "v"(hi)); return r; }
typedef float f32x2 __attribute__((ext_vector_type(2)));
template <class Epi, class Sched, bool ALIGN_EPI = false, bool SP2 = false>
__device__ __forceinline__ void gemm_phase(PG8_LAS unsigned char* lds, const Gemm g, const Sched& S, const Epi& E) {
    int tid_ = threadIdx.x; asm volatile("" : "+v"(tid_));
    const int tid = tid_, wid = __builtin_amdgcn_readfirstlane(tid >> 6), lane = tid & 63, wr = wid >> 2, wc = wid & 3, fr = lane & 15, fq = lane >> 4;
    const int K = g.K, nt = g.KL / BK;
    unsigned voffA[2], voffB[2];
#pragma unroll
    for (int i = 0; i < 2; ++i) { int R, C; stage_rc(tid * 16 + i * 8192, R, C); const int Rb = Epi::PERM ? ((R & ~31) + perm32(R & 31)) : R;
        voffA[i] = (unsigned)(R * K + C) * 2u; voffB[i] = (unsigned)(Rb * K + C) * 2u; }
    const size_t kstep = (size_t)(BK * 2);
    const size_t hstep = (size_t)HALF * K * 2;
    const size_t tstep = 2 * hstep;
    const unsigned ldsw = (unsigned)wid * 1024u;
    const int aoff = lds_byte(wr * 64 + fr, fq * 8), boff = lds_byte(wc * 32 + fr, fq * 8);
#define PG8_SA(b, h) (((b) * 2 + (h)) * HTB)
#define PG8_SB(b, h) ((4 + (b) * 2 + (h)) * HTB)
#define PG8_STAGE(bufoff, gbase, voff) do { _Pragma("unroll") for (int _i = 0; _i < 2; ++_i) \
        __builtin_amdgcn_global_load_lds((const unsigned*)((const char*)(gbase) + (voff)[_i]), (PG8_LAS unsigned*)(lds + (bufoff) + ldsw + _i * 8192), 16, 0, 0); } while (0)
#define PG8_LDA(dst, b, h) do { _Pragma("unroll") for (int m = 0; m < 4; ++m) _Pragma("unroll") for (int k = 0; k < 2; ++k) dst[m][k] = *(const PG8_LAS bf16x8*)(lds + PG8_SA(b, h) + aoff + m * 2048 + k * 1024); } while (0)
#define PG8_LDB(dst, b, h) do { _Pragma("unroll") for (int n = 0; n < 2; ++n) _Pragma("unroll") for (int k = 0; k < 2; ++k) dst[n][k] = *(const PG8_LAS bf16x8*)(lds + PG8_SB(b, h) + boff + n * 2048 + k * 1024); } while (0)
#define PG8_MMA(ai, bj, At, Bt) do { __builtin_amdgcn_s_setprio(1); _Pragma("unroll") for (int m = 0; m < 4; ++m) _Pragma("unroll") for (int n = 0; n < 2; ++n) _Pragma("unroll") for (int k = 0; k < 2; ++k) \
        acc[ai][bj][m][n] = __builtin_amdgcn_mfma_f32_16x16x32_bf16(Bt[n][k], At[m][k], acc[ai][bj][m][n], 0, 0, 0); __builtin_amdgcn_s_setprio(0); } while (0)
#define PG8_WAIT_V(n) asm volatile("s_waitcnt vmcnt(" #n ")" ::: "memory")
#define PG8_WAIT_L(n) asm volatile("s_waitcnt lgkmcnt(" #n ")" ::: "memory")
#define PG8_BAR __builtin_amdgcn_s_barrier()
#define PG8_SCHED __builtin_amdgcn_sched_barrier(0)
    Unit cur, nxt; int ui = 0;
    if (!S.next(0, cur)) return;
    f32x4 acc[2][2][4][2];
#pragma unroll
    for (int a = 0; a < 2; ++a)
#pragma unroll
        for (int b = 0; b < 2; ++b)
#pragma unroll
            for (int m = 0; m < 4; ++m)
#pragma unroll
                for (int n = 0; n < 2; ++n) acc[a][b][m][n] = (f32x4){0.f, 0.f, 0.f, 0.f};
    bf16x8 At[4][2], B0[2][2], B1[2][2];
#define PG8_PA(u) ((const char*)g.A + (size_t)(u).pm * tstep + (size_t)((u).pn / g.nNr) * (size_t)g.KL * 2)
#define PG8_PB(u) ((const char*)g.Bt + (size_t)((u).pn % g.nNr) * tstep + (size_t)((u).pn / g.nNr) * (size_t)g.KL * 2)
    const char* cA = PG8_PA(cur); const char* cB = PG8_PB(cur);
    S.a_ready(cur);
    if constexpr (SP2) {
        PG8_STAGE(PG8_SB(0, 0), cB, voffB); PG8_STAGE(PG8_SB(0, 1), cB + hstep, voffB); PG8_STAGE(PG8_SA(0, 0), cA, voffA); PG8_STAGE(PG8_SA(0, 1), cA + hstep, voffA);
        if (wr == 1) PG8_BAR;
        PG8_WAIT_V(2); PG8_BAR;
        PG8_STAGE(PG8_SB(1, 0), cB + kstep, voffB); PG8_STAGE(PG8_SA(1, 0), cA + kstep, voffA); PG8_STAGE(PG8_SB(1, 1), cB + hstep + kstep, voffB);
        PG8_WAIT_V(6); PG8_BAR;
    } else {
        PG8_STAGE(PG8_SB(0, 0), cB, voffB); PG8_STAGE(PG8_SA(0, 0), cA, voffA); PG8_STAGE(PG8_SB(0, 1), cB + hstep, voffB); PG8_STAGE(PG8_SA(0, 1), cA + hstep, voffA);
        if (wr == 1) PG8_BAR;
        PG8_WAIT_V(4); PG8_BAR;
        PG8_STAGE(PG8_SB(1, 0), cB + kstep, voffB); PG8_STAGE(PG8_SA(1, 0), cA + kstep, voffA); PG8_STAGE(PG8_SB(1, 1), cB + hstep + kstep, voffB);
        PG8_WAIT_V(6); PG8_BAR;
    }
    for (;;) {
        const bool has_next = S.next(ui + 1, nxt);
        const char* nA = has_next ? PG8_PA(nxt) : cA; const char* nB = has_next ? PG8_PB(nxt) : cB;
        for (int t = 0; t < nt; t += 2) {
            const bool last = (t == nt - 2);
            const char* a1 = cA + (size_t)(t + 1) * kstep;
            const char* a2 = last ? nA : cA + (size_t)(t + 2) * kstep; const char* b2 = last ? nB : cB + (size_t)(t + 2) * kstep;
            const char* a3 = a2 + kstep; const char* b3 = b2 + kstep;
            if (last && has_next) S.a_ready(nxt);
            if constexpr (SP2) {
            PG8_LDB(B0, 0, 0); PG8_LDB(B1, 0, 1); PG8_SCHED; PG8_LDA(At, 0, 0); PG8_STAGE(PG8_SA(1, 1), a1 + hstep, voffA);
            PG8_WAIT_V(8); PG8_WAIT_L(0); PG8_BAR; PG8_MMA(0, 0, At, B0); PG8_MMA(0, 1, At, B1); PG8_BAR; PG8_SCHED;
            PG8_LDA(At, 0, 1); PG8_STAGE(PG8_SB(0, 0), b2, voffB); PG8_STAGE(PG8_SB(0, 1), b2 + hstep, voffB); PG8_STAGE(PG8_SA(0, 0), a2, voffA);
            PG8_WAIT_V(8); PG8_WAIT_L(0); PG8_BAR; PG8_MMA(1, 0, At, B0); PG8_MMA(1, 1, At, B1); PG8_BAR; PG8_SCHED;
            PG8_LDB(B0, 1, 0); PG8_LDB(B1, 1, 1); PG8_SCHED; PG8_LDA(At, 1, 0); PG8_STAGE(PG8_SA(0, 1), a2 + hstep, voffA);
            PG8_WAIT_V(8); PG8_WAIT_L(0); PG8_BAR; PG8_MMA(0, 0, At, B0); PG8_MMA(0, 1, At, B1); PG8_BAR; PG8_SCHED;
            PG8_LDA(At, 1, 1); PG8_STAGE(PG8_SB(1, 0), b3, voffB); PG8_STAGE(PG8_SB(1, 1), b3 + hstep, voffB); PG8_STAGE(PG8_SA(1, 0), a3, voffA);
            PG8_WAIT_V(8); PG8_WAIT_L(0); PG8_BAR; PG8_MMA(1, 0, At, B0); PG8_MMA(1, 1, At, B1); PG8_BAR; PG8_SCHED;
            } else {
            PG8_LDB(B0, 0, 0); PG8_SCHED; PG8_LDA(At, 0, 0); PG8_STAGE(PG8_SA(1, 1), a1 + hstep, voffA);
            PG8_WAIT_L(8); PG8_BAR; PG8_WAIT_L(0); PG8_MMA(0, 0, At, B0); PG8_BAR; PG8_SCHED;
            PG8_LDB(B1, 0, 1); PG8_STAGE(PG8_SB(0, 0), b2, voffB);
            PG8_BAR; PG8_WAIT_L(0); PG8_MMA(0, 1, At, B1); PG8_BAR;
            PG8_LDA(At, 0, 1); PG8_STAGE(PG8_SA(0, 0), a2, voffA);
            PG8_BAR; PG8_WAIT_L(0); PG8_MMA(1, 0, At, B0); PG8_BAR; PG8_SCHED;
            PG8_STAGE(PG8_SB(0, 1), b2 + hstep, voffB);
            PG8_WAIT_V(6); PG8_BAR; PG8_MMA(1, 1, At, B1); PG8_BAR;
            PG8_LDB(B0, 1, 0); PG8_SCHED; PG8_LDA(At, 1, 0); PG8_STAGE(PG8_SA(0, 1), a2 + hstep, voffA);
            PG8_WAIT_L(8); PG8_BAR; PG8_WAIT_L(0); PG8_MMA(0, 0, At, B0); PG8_BAR; PG8_SCHED;
            PG8_LDB(B1, 1, 1); PG8_STAGE(PG8_SB(1, 0), b3, voffB);
            PG8_BAR; PG8_WAIT_L(0); PG8_MMA(0, 1, At, B1); PG8_BAR;
            PG8_LDA(At, 1, 1); PG8_STAGE(PG8_SA(1, 0), a3, voffA);
            PG8_BAR; PG8_WAIT_L(0); PG8_MMA(1, 0, At, B0); PG8_BAR; PG8_SCHED;
            PG8_STAGE(PG8_SB(1, 1), b3 + hstep, voffB);
            PG8_WAIT_V(6); PG8_BAR; PG8_MMA(1, 1, At, B1); PG8_BAR;
            }
        }
        if constexpr (ALIGN_EPI) { if (wr == 0) PG8_BAR; }
        if constexpr (!Epi::AFTER_DRAIN) { E(acc, cur, wr, wc, fr, fq); S.done(cur); }
        if (!has_next) break;
#pragma unroll
        for (int a = 0; a < 2; ++a)
#pragma unroll
            for (int b = 0; b < 2; ++b)
#pragma unroll
                for (int m = 0; m < 4; ++m)
#pragma unroll
                    for (int n = 0; n < 2; ++n) acc[a][b][m][n] = (f32x4){0.f, 0.f, 0.f, 0.f};
        cur = nxt; cA = nA; cB = nB; ++ui;
        if constexpr (ALIGN_EPI) { if (wr == 1) PG8_BAR; }
    }
    PG8_WAIT_V(0);
    if constexpr (!ALIGN_EPI) { if (wr == 0) PG8_BAR; }
    PG8_BAR;
    if constexpr (Epi::AFTER_DRAIN) { E.fused(acc, cur, wr, wc, fr, fq, lds, wid, lane); S.done(cur); }
#undef PG8_SA
#undef PG8_SB
#undef PG8_STAGE
#undef PG8_LDA
#undef PG8_LDB
#undef PG8_MMA
#undef PG8_WAIT_V
#undef PG8_WAIT_L
#undef PG8_BAR
#undef PG8_SCHED
}
}
namespace attn_body {
using bf16=__hip_bfloat16;
using bf16x8=__attribute__((ext_vector_type(8)))short;
using s16x4=__attribute__((ext_vector_type(4)))short;
using f32x16=__attribute__((ext_vector_type(16)))float;
using u32x4=__attribute__((ext_vector_type(4)))unsigned;
constexpr int D=64,QP=1280,OP=1024;
constexpr int NW=8,QBLK=32,QB=QBLK*NW,KVBLK=64;
__device__ __forceinline__ int crow(int r,int hi){return (r&3)+8*(r>>2)+4*hi;}
#define SBAR() __builtin_amdgcn_sched_barrier(0)
__device__ __forceinline__ void wmask(f32x16&p0,f32x16&p1,int kb,int qpos){
  const float NEG=-INFINITY;
  #pragma unroll
  for(int r=0;r<16;++r){int dv=kb+(r&3)+8*(r>>2)-qpos; if(dv>128||dv<-128)p0[r]=NEG; if(dv+32>128||dv+32<-128)p1[r]=NEG;}
}

constexpr int NSLOT=3, SLOTB=8192;
constexpr int LDS_K=0, LDS_V=NSLOT*SLOTB, LDS_WS=2*NSLOT*SLOTB, LDS_OST=LDS_WS+NW*64*4, LDS_BYTES=LDS_OST+NW*4096;
constexpr float C2=0.125f*1.4426950408889634f;
__device__ __forceinline__ void glds16(const void*gsrc,unsigned lds_dst){unsigned keep;
  asm volatile("s_mov_b32 %0, m0\n\ts_mov_b32 m0, %2\n\ts_nop 0\n\tglobal_load_lds_dwordx4 %1, off\n\ts_mov_b32 m0, %0":"=&s"(keep):"v"(gsrc),"s"(lds_dst):"memory");}
__device__ __forceinline__ float max3f(float a,float b,float c){float r;asm("v_max3_f32 %0, %1, %2, %3":"=v"(r):"v"(a),"v"(b),"v"(c));return r;}
__device__ __forceinline__ float max2f(float a,float b){float r;asm("v_max_f32_e32 %0, %1, %2":"=v"(r):"v"(a),"v"(b));return r;}
__device__ __forceinline__ float fadd_s(float a,float b){float r;asm("v_add_f32_e32 %0, %1, %2":"=v"(r):"v"(a),"v"(b));return r;}
__device__ __forceinline__ float fsub_s(float a,float b){float r;asm("v_sub_f32_e32 %0, %1, %2":"=v"(r):"v"(a),"v"(b));return r;}
typedef float f32x2_t __attribute__((ext_vector_type(2))); typedef __bf16 bf16x2_t __attribute__((ext_vector_type(2)));
__device__ __forceinline__ unsigned cvtpk_s(float lo,float hi){f32x2_t v={lo,hi};bf16x2_t b=__builtin_convertvector(v,bf16x2_t);return __builtin_bit_cast(unsigned,b);}
#define WAIT_BAR(N) asm volatile("s_waitcnt vmcnt(" #N ") lgkmcnt(0)\n\ts_barrier":::"memory")

__device__ __forceinline__ void qkt(f32x16&p0,f32x16&p1,const char*Kslot,const bf16x8*qr,const f32x16&negm,int r32,int hi){
  const char*kb=Kslot+hi*1024+r32*16;
  #pragma unroll
  for(int d0=0;d0<4;++d0){
    const bf16x8 b0=*reinterpret_cast<const bf16x8*>(kb+d0*2048);
    const bf16x8 b1=*reinterpret_cast<const bf16x8*>(kb+d0*2048+512);
    if(d0==0){p0=__builtin_amdgcn_mfma_f32_32x32x16_bf16(b0,qr[0],negm,0,0,0);p1=__builtin_amdgcn_mfma_f32_32x32x16_bf16(b1,qr[0],negm,0,0,0);}
    else{p0=__builtin_amdgcn_mfma_f32_32x32x16_bf16(b0,qr[d0],p0,0,0,0);p1=__builtin_amdgcn_mfma_f32_32x32x16_bf16(b1,qr[d0],p1,0,0,0);}}
}
typedef __attribute__((address_space(3))) const char* lds_cptr;
typedef short v4i16_t __attribute__((ext_vector_type(4)));
__device__ __forceinline__ void kload8(bf16x8*kf,lds_cptr kp){
  kf[0]=*(const __attribute__((address_space(3))) bf16x8*)(kp);      kf[1]=*(const __attribute__((address_space(3))) bf16x8*)(kp+512);
  kf[2]=*(const __attribute__((address_space(3))) bf16x8*)(kp+2048); kf[3]=*(const __attribute__((address_space(3))) bf16x8*)(kp+2560);
  kf[4]=*(const __attribute__((address_space(3))) bf16x8*)(kp+4096); kf[5]=*(const __attribute__((address_space(3))) bf16x8*)(kp+4608);
  kf[6]=*(const __attribute__((address_space(3))) bf16x8*)(kp+6144); kf[7]=*(const __attribute__((address_space(3))) bf16x8*)(kp+6656);
}
__device__ __forceinline__ void kload2(bf16x8*kf,lds_cptr kp,int j){ kf[2*j]=*(const __attribute__((address_space(3))) bf16x8*)(kp+j*2048); kf[2*j+1]=*(const __attribute__((address_space(3))) bf16x8*)(kp+j*2048+512); }
__device__ __forceinline__ s16x4 vtr(lds_cptr p){ return __builtin_bit_cast(s16x4,__builtin_amdgcn_ds_read_tr16_b64_v4i16((__attribute__((address_space(3))) v4i16_t*)p)); }
__device__ __forceinline__ float rowmax(const f32x16&p0,const f32x16&p1){
  float a=max3f(p0[0],p0[1],p1[0]),b=max3f(p0[2],p0[3],p1[1]);a=max3f(a,p1[2],p1[3]);
  #pragma unroll
  for(int r=4;r<16;r+=4){a=max3f(a,p0[r],p0[r+1]);b=max3f(b,p0[r+2],p0[r+3]);a=max3f(a,p1[r],p1[r+1]);b=max3f(b,p1[r+2],p1[r+3]);}
  const float m=max2f(a,b);
  auto rr=__builtin_amdgcn_permlane32_swap(__float_as_uint(m),__float_as_uint(m),false,false);
  return max2f(__uint_as_float(rr[0]),__uint_as_float(rr[1]));
}
__device__ __forceinline__ void pv(f32x16*o,int vb,bf16x8 pa0,bf16x8 pa1,bf16x8 pa2,bf16x8 pa3){
  #pragma unroll
  for(int d0=0;d0<2;++d0){s16x4 lo[4],hi[4];
    #pragma unroll
    for(int ks=0;ks<4;++ks){
      asm volatile("ds_read_b64_tr_b16 %0,%1 offset:%c2":"=&v"(lo[ks]):"v"(vb),"i"(d0*4096+ks*1024):"memory");
      asm volatile("ds_read_b64_tr_b16 %0,%1 offset:%c2":"=&v"(hi[ks]):"v"(vb),"i"(d0*4096+ks*1024+512):"memory");}
    asm volatile("s_waitcnt lgkmcnt(0)":::"memory");SBAR();
    #define PK(k) (bf16x8){lo[k][0],lo[k][1],lo[k][2],lo[k][3],hi[k][0],hi[k][1],hi[k][2],hi[k][3]}
    o[d0]=__builtin_amdgcn_mfma_f32_32x32x16_bf16(pa0,PK(0),o[d0],0,0,0);
    o[d0]=__builtin_amdgcn_mfma_f32_32x32x16_bf16(pa1,PK(1),o[d0],0,0,0);
    o[d0]=__builtin_amdgcn_mfma_f32_32x32x16_bf16(pa2,PK(2),o[d0],0,0,0);
    o[d0]=__builtin_amdgcn_mfma_f32_32x32x16_bf16(pa3,PK(3),o[d0],0,0,0);
    #undef PK
  }
}

#ifndef ATTN_STORE16
#define ATTN_STORE16(p,v) (*(u32x4*)(p)=(v))
#endif
struct AttnJob { const bf16*Q; const bf16*K; const bf16*V; bf16*O; int qrow0, ctxrow0, bandrow0, NT, qpos0, kpos0; float sink2; int has_sink; };
template<int THRL,bool MASK> __device__ __forceinline__ void attn_unit(const AttnJob J,char*shm){
  int tid_=threadIdx.x; asm volatile("":"+v"(tid_)); const int tid=tid_,lane=tid&63,r32=lane&31,hi=lane>>5; const int wid=__builtin_amdgcn_readfirstlane(tid>>6);
  const bf16*Qw=J.Q+(long)(J.qrow0+wid*QBLK)*QP;
  const bf16*Kh=J.K,*Vh=J.V;
  const unsigned lds0=(unsigned)(uintptr_t)shm;
  float*wsf=(float*)(shm+LDS_WS)+wid*64;
  const bf16*ksrc=Kh+(long)lane*QP+wid*8;
  const bf16*vsrc=Vh+(long)(16*(wid&3)+(lane>>2))*QP+(wid>>2)*32+(lane&3)*8;
  const unsigned kdst=lds0+LDS_K+wid*1024, vdst=lds0+LDS_V+wid*1024;
  #define TROW(t) ((long)(((t)<4)?(J.ctxrow0+64*(t)):(J.bandrow0+64*((t)-4))))
  #define DMA_K(t,slot) glds16(ksrc+TROW(t)*QP,(unsigned)__builtin_amdgcn_readfirstlane(kdst+(slot)))
  #define DMA_V(t,slot) glds16(vsrc+TROW(t)*QP,(unsigned)__builtin_amdgcn_readfirstlane(vdst+(slot)))
  const int vb0=(int)(lds0+LDS_V)+((lane>>4)&1)*32+(lane&3)*8+(4*hi+((lane&15)>>2))*64;
  const char*Kbase=shm+LDS_K; bf16x8 kf[8];
  const lds_cptr shm3=(lds_cptr)shm; const lds_cptr kp0=shm3+LDS_K+hi*1024+r32*16; const lds_cptr vp0=shm3+LDS_V+((lane>>4)&1)*32+(lane&3)*8+(4*hi+((lane&15)>>2))*64;
  const int NT=J.NT;
  DMA_K(0,0);DMA_V(0,0);DMA_K(1,SLOTB);
  bf16x8 qr[4];
  #pragma unroll
  for(int d0=0;d0<4;++d0)qr[d0]=*reinterpret_cast<const bf16x8*>(&Qw[(long)r32*QP+d0*16+hi*8]);
  float mhat=0.f,l_reg=0.f;f32x16 o[2];o[0]=f32x16{};o[1]=f32x16{};f32x16 negm=f32x16{};asm volatile("":"+v"(negm));
  const int qpos=J.qpos0+wid*QBLK+r32;
  #define CMASK(P0,P1,t) do{ if constexpr(MASK){ if((t)>=4) wmask(P0,P1,J.kpos0+64*((t)-4)+4*hi,qpos); } }while(0)
  bool resc=false;
  #define START(P0,P1) do{ const float rm=rowmax(P0,P1); resc=false; \
    { const float dl=rm; mhat=fadd_s(mhat,dl); \
      _Pragma("unroll") for(int r=0;r<16;++r){P0[r]=fsub_s(P0[r],dl);P1[r]=fsub_s(P1[r],dl);} \
      _Pragma("unroll") for(int r=0;r<16;++r)negm[r]=-mhat; asm volatile("":"+v"(negm)); } \
    _Pragma("unroll") for(int r=0;r<16;++r)P0[r]=__builtin_amdgcn_exp2f(P0[r]); }while(0)
  #define RESC() do{ if(resc){ asm volatile("s_waitcnt lgkmcnt(0)":::"memory"); \
      _Pragma("unroll") for(int d_=0;d_<2;++d_) _Pragma("unroll") for(int r=0;r<16;++r)o[d_][r]*=wsf[crow(r,hi)]; } }while(0)
  f32x16 pA0,pA1,pB0,pB1;
  int sl_prev=0,sl_cur=0,sl_next=SLOTB;
  #define ROT() do{sl_prev=sl_cur;sl_cur=sl_next;sl_next=(sl_next==(NSLOT-1)*SLOTB)?0:sl_next+SLOTB;}while(0)
  DMA_K(2,2*SLOTB);
  WAIT_BAR(3);
  qkt(pA0,pA1,Kbase,qr,negm,r32,hi);asm volatile("s_nop 15\n\ts_nop 7":"+v"(pA0),"+v"(pA1));CMASK(pA0,pA1,0);
  START(pA0,pA1);
  _Pragma("unroll") for(int r=0;r<16;++r)pA1[r]=__builtin_amdgcn_exp2f(pA1[r]);
  WAIT_BAR(0);
  DMA_K(3,0);DMA_V(1,SLOTB);
  ROT();
  kload8(kf,kp0+sl_cur);
  WAIT_BAR(2);
  s16x4 vlo[8],vhi[8]; u32x4 pw0,pw1,pw2,pw3;
  #define PKW(P,B) cvtpk_s(P[B],P[B+1])
  #define PAF(k) __builtin_bit_cast(bf16x8,pw##k)
  #define VFR(i) (bf16x8){vlo[i][0],vlo[i][1],vlo[i][2],vlo[i][3],vhi[i][0],vhi[i][1],vhi[i][2],vhi[i][3]}
  #define PIN(x) asm volatile("":"+v"(x))
  #define MX3(a,b,c) __builtin_fmaxf(__builtin_fmaxf((a),(b)),(c))
  #define GAPA(MF,A0,A1,A2,A3,W0,W1,PW) do{ MF; sacc+=A0; sacc+=A1; sacc+=A2; sacc+=A3; PIN(sacc); W0; W1; PIN(PW); SBAR(); }while(0)
  #define EX(v) __builtin_amdgcn_exp2f(v)
  #define GAPB(MF,X,B) do{ MF; X[B]=EX(X[B]); X[B+1]=EX(X[B+1]); X[B+2]=EX(X[B+2]); X[B+3]=EX(X[B+3]); PIN(X); SBAR(); }while(0)
  #define VRD(i) do{ vlo[i]=vtr(vp_+(((i)>>2)*4096+((i)&3)*1024)); vhi[i]=vtr(vp_+(((i)>>2)*4096+((i)&3)*1024+512)); }while(0)
  #define KRD(G,j) do{ if(G){ kload2(kf,kp0+sl_next,j); SBAR(); } }while(0)
  #define STEP(C0,C1,P0,P1,t,GK,GV,GL) do{ SBAR(); \
    const lds_cptr vp_=vp0+sl_prev; \
    VRD(0); SBAR(); float sacc=(P0[0]+P0[1]); \
    GAPA(C0=__builtin_amdgcn_mfma_f32_32x32x16_bf16(kf[0],qr[0],negm,0,0,0), P0[2],P0[3],P0[4],P0[5],     pw0[0]=PKW(P0,0), pw0[1]=PKW(P0,2), pw0); \
    VRD(4); SBAR(); GAPA(C1=__builtin_amdgcn_mfma_f32_32x32x16_bf16(kf[1],qr[0],negm,0,0,0), P0[6],P0[7],P0[8],P0[9],     pw0[2]=PKW(P0,4), pw0[3]=PKW(P0,6), pw0); \
    VRD(1); SBAR(); GAPA(C0=__builtin_amdgcn_mfma_f32_32x32x16_bf16(kf[2],qr[1],C0,0,0,0),   P0[10],P0[11],P0[12],P0[13], pw1[0]=PKW(P0,8), pw1[1]=PKW(P0,10), pw1); \
    VRD(5); SBAR(); GAPA(C1=__builtin_amdgcn_mfma_f32_32x32x16_bf16(kf[3],qr[1],C1,0,0,0),   P0[14],P0[15],P1[0],P1[1],   pw1[2]=PKW(P0,12),pw1[3]=PKW(P0,14), pw1); \
    VRD(2); SBAR(); GAPA(C0=__builtin_amdgcn_mfma_f32_32x32x16_bf16(kf[4],qr[2],C0,0,0,0),   P1[2],P1[3],P1[4],P1[5],     pw2[0]=PKW(P1,0), pw2[1]=PKW(P1,2), pw2); \
    VRD(6); SBAR(); GAPA(C1=__builtin_amdgcn_mfma_f32_32x32x16_bf16(kf[5],qr[2],C1,0,0,0),   P1[6],P1[7],P1[8],P1[9],     pw2[2]=PKW(P1,4), pw2[3]=PKW(P1,6), pw2); \
    VRD(3); SBAR(); GAPA(C0=__builtin_amdgcn_mfma_f32_32x32x16_bf16(kf[6],qr[3],C0,0,0,0),   P1[10],P1[11],P1[12],P1[13], pw3[0]=PKW(P1,8), pw3[1]=PKW(P1,10), pw3); \
    VRD(7); SBAR(); GAPA(C1=__builtin_amdgcn_mfma_f32_32x32x16_bf16(kf[7],qr[3],C1,0,0,0),   P1[14],P1[15],0.f,0.f,       pw3[2]=PKW(P1,12),pw3[3]=PKW(P1,14), pw3); \
    l_reg+=sacc; \
    if(GK){DMA_K((t)+3,sl_cur);} if(GV){DMA_V((t)+1,sl_next);} \
    CMASK(C0,C1,t); \
    { float a=MX3(C0[0],C0[1],C1[0]),b=MX3(C0[2],C0[3],C1[1]); a=MX3(a,C1[2],C1[3]); \
      _Pragma("unroll") for(int r=4;r<16;r+=4){a=MX3(a,C0[r],C0[r+1]);b=MX3(b,C0[r+2],C0[r+3]);a=MX3(a,C1[r],C1[r+1]);b=MX3(b,C1[r+2],C1[r+3]);} \
      float rm=__builtin_fmaxf(a,b); { auto rr=__builtin_amdgcn_permlane32_swap(__float_as_uint(rm),__float_as_uint(rm),false,false); rm=__builtin_fmaxf(__uint_as_float(rr[0]),__uint_as_float(rr[1])); } \
      resc=false; \
      if(__builtin_expect(__any(rm>(float)THRL),0)){ const float dl=__builtin_fmaxf(rm,0.f); mhat+=dl; \
        _Pragma("unroll") for(int r=0;r<16;++r){C0[r]-=dl;C1[r]-=dl;} \
        _Pragma("unroll") for(int r=0;r<16;++r)negm[r]=-mhat; asm volatile("":"+v"(negm)); \
        const float f=__builtin_amdgcn_exp2f(-dl); l_reg*=f; if(hi==0)wsf[r32]=f; resc=true; } } \
    SBAR(); \
    GAPB(o[0]=__builtin_amdgcn_mfma_f32_32x32x16_bf16(PAF(0),VFR(0),o[0],0,0,0), C0,0); \
    GAPB(o[1]=__builtin_amdgcn_mfma_f32_32x32x16_bf16(PAF(0),VFR(4),o[1],0,0,0), C0,4); \
    KRD(GL,0); GAPB(o[0]=__builtin_amdgcn_mfma_f32_32x32x16_bf16(PAF(1),VFR(1),o[0],0,0,0), C0,8); \
    KRD(GL,1); GAPB(o[1]=__builtin_amdgcn_mfma_f32_32x32x16_bf16(PAF(1),VFR(5),o[1],0,0,0), C0,12); \
    KRD(GL,2); GAPB(o[0]=__builtin_amdgcn_mfma_f32_32x32x16_bf16(PAF(2),VFR(2),o[0],0,0,0), C1,0); \
    KRD(GL,3); GAPB(o[1]=__builtin_amdgcn_mfma_f32_32x32x16_bf16(PAF(2),VFR(6),o[1],0,0,0), C1,4); \
    GAPB(o[0]=__builtin_amdgcn_mfma_f32_32x32x16_bf16(PAF(3),VFR(3),o[0],0,0,0), C1,8); \
    GAPB(o[1]=__builtin_amdgcn_mfma_f32_32x32x16_bf16(PAF(3),VFR(7),o[1],0,0,0), C1,12); \
    }while(0)
  int t=1;
  for(;t+5<NT;t+=2){
    STEP(pB0,pB1,pA0,pA1,t,true,true,true);     WAIT_BAR(2); RESC(); ROT();
    STEP(pA0,pA1,pB0,pB1,t+1,true,true,true);   WAIT_BAR(2); RESC(); ROT();
  }
  #define ENDW(tt) do{ if((tt)+3<NT){WAIT_BAR(2);} else if((tt)+2<NT){WAIT_BAR(1);} else {WAIT_BAR(0);} }while(0)
  for(;t+1<NT;t+=2){
    STEP(pB0,pB1,pA0,pA1,t,(t+3<NT),(t+1<NT),(t+1<NT));       ENDW(t);   RESC(); ROT();
    STEP(pA0,pA1,pB0,pB1,t+1,(t+4<NT),(t+2<NT),(t+2<NT));     ENDW(t+1); RESC(); ROT();
  }
  STEP(pB0,pB1,pA0,pA1,NT-1,false,false,false); RESC();
  { float sacc=pB0[0]+pB0[1]; _Pragma("unroll") for(int r=2;r<16;++r)sacc+=pB0[r]; _Pragma("unroll") for(int r=0;r<16;++r)sacc+=pB1[r]; l_reg+=sacc;
    pw0=(u32x4){PKW(pB0,0),PKW(pB0,2),PKW(pB0,4),PKW(pB0,6)};pw1=(u32x4){PKW(pB0,8),PKW(pB0,10),PKW(pB0,12),PKW(pB0,14)};pw2=(u32x4){PKW(pB1,0),PKW(pB1,2),PKW(pB1,4),PKW(pB1,6)};pw3=(u32x4){PKW(pB1,8),PKW(pB1,10),PKW(pB1,12),PKW(pB1,14)};
    SBAR(); pv(o,vb0+sl_cur,PAF(0),PAF(1),PAF(2),PAF(3)); }
  #undef PKW
  #undef PAF
  #undef VFR
  #undef PIN
  #undef MX3
  #undef GAPA
  #undef GAPB
  #undef EX
  #undef VRD
  #undef KRD
  #undef STEP
  #undef ENDW
  {auto rr=__builtin_amdgcn_permlane32_swap(__float_as_uint(l_reg),__float_as_uint(l_reg),false,false);l_reg=__uint_as_float(rr[0])+__uint_as_float(rr[1]);}
  if(J.has_sink)l_reg+=__builtin_amdgcn_exp2f(J.sink2-mhat);
  if(hi==0)wsf[32+r32]=l_reg;asm volatile("s_waitcnt lgkmcnt(0)":::"memory");
  float rli[16];
  #pragma unroll
  for(int r=0;r<16;++r)rli[r]=__builtin_amdgcn_rcpf(wsf[32+crow(r,hi)]);
  bf16*Ow=J.O+(long)(J.qrow0+wid*QBLK)*OP;
  { bf16*stg=(bf16*)(shm+LDS_OST)+wid*2048;
    #pragma unroll
    for(int r=0;r<16;++r){const int orow=crow(r,hi);
      #pragma unroll
      for(int d0=0;d0<2;++d0)stg[orow*64+d0*32+r32]=__float2bfloat16(o[d0][r]*rli[r]);}
    asm volatile("s_waitcnt lgkmcnt(0)":::"memory");
    #pragma unroll
    for(int i=0;i<4;++i){const int row=i*8+(lane>>3),ch=lane&7; const u32x4 v=*(const u32x4*)(stg+row*64+ch*8); ATTN_STORE16(Ow+(long)row*OP+ch*8,v);} }
  asm volatile("s_waitcnt lgkmcnt(0)\n\ts_barrier":::"memory");
  #undef DMA_K
  #undef TROW
  #undef DMA_V
  #undef CMASK
  #undef START
  #undef RESC
  #undef ROT
}
constexpr int ATTN_LDS_BYTES=LDS_BYTES;
#undef SBAR
#undef WAIT_BAR
}
#define LAS __attribute__((address_space(3)))
typedef unsigned short bf16_t;
typedef float f32x4 __attribute__((ext_vector_type(4)));
typedef unsigned u32x4 __attribute__((ext_vector_type(4)));
typedef unsigned u32x2 __attribute__((ext_vector_type(2)));
typedef float cf2 __attribute__((ext_vector_type(2)));
__device__ __forceinline__ cf2 mk2(float x, float y) { cf2 r; r.x = x; r.y = y; return r; }
constexpr int DM = 1024, NBATCH = 2, SEQ = 16384, DEPTH = 4, CTXL = 256, DFF = 2816, DIN = 2304, NMODV = 9 * 1024;
constexpr int MLAT = NBATCH * SEQ, MTOT = MLAT + NBATCH * CTXL;
constexpr int PBP = 1280;
constexpr float EPSF = 1e-6f;
constexpr float QC2 = 0.125f * 1.4426950408889634f;
constexpr float LOG2E = 1.4426950408889634f;
constexpr int NTHREADS = 512, NWAVES = 8;
constexpr int LDS_BYTES = 147456;
constexpr size_t MiB = 1u << 20;
constexpr size_t WS_MOD = 1 * MiB, WS_TW14 = 2 * MiB, WS_TW15 = 2 * MiB + 131072, WS_TWA = 2 * MiB + 262144, WS_TWB = 2 * MiB + 393216, WS_H2 = 3 * MiB, WS_H2C = 7 * MiB, WS_XC = 8 * MiB;
constexpr size_t WS_W13A = 10 * MiB, WS_W13B = 21 * MiB, WS_W2A = 32 * MiB, WS_W2B = WS_W2A + 5767168, WS_WIN = 43 * MiB, WS_WOUT = WS_WIN + 4718592, WS_WLRU = WS_WOUT + 2 * MiB;
constexpr size_t WS_XN = 50 * MiB;
constexpr size_t WS_SCR = 116 * MiB;
constexpr size_t WS_H = WS_SCR;
constexpr size_t WS_PB = WS_SCR, WS_R = 198 * MiB, WS_UT = 215 * MiB, WS_KF = 311 * MiB, WS_AB = 375 * MiB, WS_PA = WS_AB;
constexpr size_t WS_UC = 505 * MiB;
constexpr size_t WS_SUM = 507 * MiB, WS_CAR = 508 * MiB;
constexpr size_t WS_PART = 509 * MiB;
constexpr size_t WS_RAW0 = WS_KF, WS_RAW1 = 532 * MiB;
constexpr size_t WS_END = 565 * MiB;
static_assert(WS_WLRU + 524288 <= WS_XN && WS_XN + (size_t)MTOT * 1024 * 2 <= WS_SCR && WS_H + (size_t)MTOT * DFF * 2 <= WS_END, "ws map");
static_assert(WS_PB + (size_t)MTOT * PBP * 2 <= WS_R && WS_R + (size_t)MTOT * 256 * 2 <= WS_UT && WS_UT + (size_t)6 * 256 * SEQ * 4 <= WS_KF && WS_KF + (size_t)256 * 262144 <= WS_AB && WS_AB + (size_t)2 * MTOT * 256 * 8 <= WS_END, "ws map 2");

struct Args { const float* in[32]; float* out; unsigned char* ws; };
typedef const Args __attribute__((address_space(4)))* ArgsP;
__device__ __forceinline__ ArgsP args_ptr() { ArgsP p = (ArgsP)__builtin_amdgcn_kernarg_segment_ptr(); asm volatile("" : "+s"(p)); return p; }
enum { I_X = 0, I_C, I_CTX, I_CCTX, I_WMOD, I_BMOD, I_NORMG, I_F1W13, I_F1W2, I_F2W13, I_F2W2, I_WIN, I_WOUT, I_HYCW, I_HYCB, I_HYW1, I_HYB1, I_HYFREQ, I_HYW2, I_HYB2, I_HYW3, I_HYSKIP,
       I_LRUCW, I_LRUCB, I_LRUWA, I_LRUBA, I_LRUWX, I_LRUBX, I_LRULAM, I_SINK, I_QKGAIN, I_FINALG };

__device__ __forceinline__ unsigned f2bf(float f) { unsigned u = __float_as_uint(f); return (u + 0x7fffu + ((u >> 16) & 1u)) >> 16; }
__device__ __forceinline__ unsigned pk2(float lo, float hi) { return f2bf(lo) | (f2bf(hi) << 16); }
__device__ __forceinline__ float bflo(unsigned w) { return __uint_as_float(w << 16); }
__device__ __forceinline__ float bfhi(unsigned w) { return __uint_as_float(w & 0xffff0000u); }
__device__ __forceinline__ float bf2f(bf16_t h) { return __uint_as_float(((unsigned)h) << 16); }
__device__ __forceinline__ float wave_sum(float v) {
#pragma unroll
    for (int o = 1; o < 64; o <<= 1) v += __shfl_xor(v, o);
    return v;
}
__device__ __forceinline__ void unpack8(const u32x4 w, float (&v)[8]) { v[0] = bflo(w.x); v[1] = bfhi(w.x); v[2] = bflo(w.y); v[3] = bfhi(w.y); v[4] = bflo(w.z); v[5] = bfhi(w.z); v[6] = bflo(w.w); v[7] = bfhi(w.w); }
__device__ __forceinline__ u32x4 pack8(const float (&v)[8]) { u32x4 w; w.x = pg8::cvt_pk_bf16(v[0], v[1]); w.y = pg8::cvt_pk_bf16(v[2], v[3]); w.z = pg8::cvt_pk_bf16(v[4], v[5]); w.w = pg8::cvt_pk_bf16(v[6], v[7]); return w; }
__device__ __forceinline__ float* xrow_ptr(ArgsP a, int row) { return row < MLAT ? a->out + (size_t)row * DM : (float*)(a->ws + WS_XC) + (size_t)(row - MLAT) * DM; }
__device__ __forceinline__ int mod_index(int row) { return row < MLAT ? (row >> 14) : 2; }
__device__ __forceinline__ float sigmoidf_(float x) { return 1.f / (1.f + __expf(-x)); }

struct EpiSwiGLU {
    static constexpr bool PERM = true, AFTER_DRAIN = false;
    bf16_t* H;
    __device__ __forceinline__ void operator()(const pg8::f32x4 (&acc)[2][2][4][2], const pg8::Unit& u, int wr, int wc, int fr, int fq) const {
#ifndef STUB_EpiSwiGLU
        const int row0 = u.pm * 256 + wr * 64 + fr, col0 = u.pn * 128 + wc * 32 + 8 * fq;
#pragma unroll
        for (int ai = 0; ai < 2; ++ai)
#pragma unroll
            for (int m = 0; m < 4; ++m) {
                float v[8];
#pragma unroll
                for (int n = 0; n < 2; ++n)
#pragma unroll
                    for (int i = 0; i < 4; ++i) { const float g = acc[ai][0][m][n][i], up = acc[ai][1][m][n][i]; v[4 * n + i] = g * __builtin_amdgcn_rcpf(1.f + __expf(-g)) * up; }
                *(u32x4*)(H + (size_t)(row0 + ai * 128 + m * 16) * DFF + col0) = pack8(v);
            }
#endif
    }
};
struct EpiResid {
    static constexpr bool PERM = false, AFTER_DRAIN = false;
    float* Xlat; float* Xctx; const float* gate; float gs; const float* Xin;
    __device__ __forceinline__ void operator()(const pg8::f32x4 (&acc)[2][2][4][2], const pg8::Unit& u, int wr, int wc, int fr, int fq) const {
#ifndef STUB_EpiResid
        const int mi = u.pm < 128 ? (u.pm >> 6) : 2;
        float* base = u.pm < 128 ? Xlat + (size_t)u.pm * 256 * DM : Xctx + (size_t)(u.pm - 128) * 256 * DM;
        const float* rbase = u.pm < 128 ? Xin + (size_t)u.pm * 256 * DM : base;
#pragma unroll
        for (int bj = 0; bj < 2; ++bj)
#pragma unroll
            for (int n = 0; n < 2; ++n) {
                const int c = 256 * u.pn + 128 * bj + 32 * wc + 16 * n + 4 * fq;
                const f32x4 gv = *(const f32x4*)(gate + (size_t)mi * NMODV + c) * gs;
#pragma unroll
                for (int ai = 0; ai < 2; ++ai)
#pragma unroll
                    for (int m = 0; m < 4; ++m) { const size_t off = (size_t)(128 * ai + 64 * wr + 16 * m + fr) * DM + c; *(f32x4*)(base + off) = *(const f32x4*)(rbase + off) + gv * acc[ai][bj][m][n]; if (m & 1) asm volatile("" ::: "memory"); }
            }
#endif
    }
};
struct EpiResidCtxSplitK {
    static constexpr bool PERM = false, AFTER_DRAIN = false;
    float* PART; const float* gate; float gs; int nNr;
    __device__ __forceinline__ void operator()(const pg8::f32x4 (&acc)[2][2][4][2], const pg8::Unit& u, int wr, int wc, int fr, int fq) const {
        const int pn = u.pn % nNr, ks = u.pn / nNr; const int c0 = 256 * pn + 32 * wc + 4 * fq;
        f32x4 gv[2][2];
#pragma unroll
        for (int bj = 0; bj < 2; ++bj)
#pragma unroll
            for (int n = 0; n < 2; ++n) gv[bj][n] = *(const f32x4*)(gate + (size_t)2 * NMODV + c0 + 128 * bj + 16 * n) * gs;
        float* base = PART + ((size_t)ks * (NBATCH * CTXL) + u.pm * 256 + 64 * wr + fr) * DM + c0;
#pragma unroll
        for (int ai = 0; ai < 2; ++ai)
#pragma unroll
            for (int m = 0; m < 4; ++m) {
                float* p = base + (size_t)(128 * ai + 16 * m) * DM;
#pragma unroll
                for (int bj = 0; bj < 2; ++bj)
#pragma unroll
                    for (int n = 0; n < 2; ++n) *(f32x4*)(p + 128 * bj + 16 * n) = gv[bj][n] * acc[ai][bj][m][n];
            }
    }
};
struct EpiProj {
    static constexpr bool PERM = true, AFTER_DRAIN = false;
    bf16_t* PA; bf16_t* PB;
    __device__ __forceinline__ void operator()(const pg8::f32x4 (&acc)[2][2][4][2], const pg8::Unit& u, int wr, int wc, int fr, int fq) const {
#ifndef STUB_EpiProj
        bf16_t* O = u.pn < 4 ? PA : PB; const int ldc = u.pn < 4 ? 1024 : PBP; const int cb = (u.pn < 4 ? u.pn : u.pn - 4) * 256 + wc * 32 + 8 * fq;
        const int row0 = u.pm * 256 + wr * 64 + fr;
#pragma unroll
        for (int ai = 0; ai < 2; ++ai)
#pragma unroll
            for (int m = 0; m < 4; ++m)
#pragma unroll
                for (int bj = 0; bj < 2; ++bj) {
                    float v[8];
#pragma unroll
                    for (int n = 0; n < 2; ++n)
#pragma unroll
                        for (int i = 0; i < 4; ++i) v[4 * n + i] = acc[ai][bj][m][n][i];
                    *(u32x4*)(O + (size_t)(row0 + ai * 128 + m * 16) * ldc + cb + bj * 128) = pack8(v);
                }
#endif
    }
};
struct EpiLru {
    static constexpr bool PERM = true, AFTER_DRAIN = false;
    unsigned* RAW0; unsigned* RAW1;
    __device__ __forceinline__ void operator()(const pg8::f32x4 (&acc)[2][2][4][2], const pg8::Unit& u, int wr, int wc, int fr, int fq) const {
#ifndef STUB_EpiLru
        const int dir = u.pn >> 1, ch0 = (u.pn & 1) * 128 + wc * 32 + 8 * fq;
        const int row0 = u.pm * 256 + wr * 64 + fr;
        unsigned* R = dir ? RAW1 : RAW0;
#pragma unroll
        for (int ai = 0; ai < 2; ++ai)
#pragma unroll
            for (int m = 0; m < 4; ++m) {
                unsigned* o = R + (size_t)(row0 + ai * 128 + m * 16) * 256 + ch0;
#pragma unroll
                for (int n = 0; n < 2; ++n) {
                    const f32x4 pa = acc[ai][0][m][n], px = acc[ai][1][m][n];
                    u32x4 w; w.x = pg8::cvt_pk_bf16(pa[0], px[0]); w.y = pg8::cvt_pk_bf16(pa[1], px[1]); w.z = pg8::cvt_pk_bf16(pa[2], px[2]); w.w = pg8::cvt_pk_bf16(pa[3], px[3]);
                    *(u32x4*)(o + 4 * n) = w;
                }
            }
#endif
    }
};
constexpr int LCH = 130, NCH = 128;
#define LRU_ROWOF(p, b, dir) ((p) < CTXL ? (size_t)MLAT + (b) * CTXL + ((dir) ? (CTXL - 1 - (p)) : (p)) : (size_t)(b) * SEQ + ((dir) ? (SEQ - 1 - ((p) - CTXL)) : ((p) - CTXL)))
__device__ __forceinline__ void lru_gate_phase(ArgsP a, int l, int tid) {
    cf2* AB = (cf2*)(a->ws + WS_AB); const bf16_t* R = (const bf16_t*)(a->ws + WS_R); cf2* SUM = (cf2*)(a->ws + WS_SUM);
    const int ch = tid & 255, half = tid >> 8;
    for (int u = blockIdx.x; u < 256; u += gridDim.x) {
        const int dir = u >> 7, b = (u >> 6) & 1, chunk = (u & 63) * 2 + half;
        const float vba = a->in[I_LRUBA][(size_t)l * 512 + dir * 256 + ch], vbx = a->in[I_LRUBX][(size_t)l * 512 + dir * 256 + ch];
        const float sp8 = -8.f * log1pf(expf(-a->in[I_LRULAM][(size_t)l * 512 + dir * 256 + ch]));
        unsigned* ABd = (unsigned*)AB + (size_t)dir * MTOT * 256 + ch; const bf16_t* Rc = R + ch; const unsigned* RWd = (const unsigned*)(a->ws + (dir ? WS_RAW1 : WS_RAW0)) + ch;
        float Ac = 1.f, h = 0.f;
#pragma unroll 1
        for (int s0 = 0; s0 < LCH; s0 += 10) {
            cf2 raw[10]; float uu[10];
#pragma unroll
            for (int j = 0; j < 10; ++j) { const size_t row = LRU_ROWOF(chunk * LCH + s0 + j, b, dir); const unsigned w = RWd[row * 256]; raw[j] = mk2(bflo(w), bfhi(w)); uu[j] = bf2f(Rc[row * 256]); }
#pragma unroll
            for (int j = 0; j < 10; ++j) {
                const float ra = __builtin_amdgcn_rcpf(1.f + __expf(-(raw[j].x + vba))), ri = __builtin_amdgcn_rcpf(1.f + __expf(-(raw[j].y + vbx)));
                const float la = ra * sp8; const float av = __expf(la); const float bv = __builtin_amdgcn_sqrtf(fmaxf(__builtin_fmaf(-av, av, 1.0f), 0.f)) * ri * uu[j];
                h = av * h + bv; Ac *= av;
                const size_t row = LRU_ROWOF(chunk * LCH + s0 + j, b, dir); ABd[row * 256] = pg8::cvt_pk_bf16(Ac, h);
            }
        }
        SUM[((size_t)((dir * 2 + b) * NCH + chunk)) * 256 + ch] = mk2(Ac, h);
    }
}
__device__ __forceinline__ void lru_carry_unit(ArgsP a, int db, int tid) {
    if (tid < 256) {
        const cf2* SUM = (const cf2*)(a->ws + WS_SUM) + (size_t)db * NCH * 256 + tid; float* CAR = (float*)(a->ws + WS_CAR) + (size_t)db * NCH * 256 + tid;
        float c = 0.f;
#pragma unroll 1
        for (int k0 = 0; k0 < NCH; k0 += 8) {
            cf2 e[8];
#pragma unroll
            for (int j = 0; j < 8; ++j) e[j] = SUM[(size_t)(k0 + j) * 256];
#pragma unroll
            for (int j = 0; j < 8; ++j) { CAR[(size_t)(k0 + j) * 256] = c; c = e[j].x * c + e[j].y; }
        }
    }
}
typedef short sbf16x8 __attribute__((ext_vector_type(8)));
typedef float sf32x16 __attribute__((ext_vector_type(16)));
__device__ __forceinline__ int crow32(int r, int hi) { return (r & 3) + 8 * (r >> 2) + 4 * hi; }
template <int NB> __device__ __forceinline__ void wave_gemm32(const bf16_t* A, const bf16_t* B0, const bf16_t* B1, int K, int lane, sf32x16 (&acc)[NB]) {
    const int r = lane & 31, kh = lane >> 5;
    const bf16_t* pa = A + (size_t)r * K + 8 * kh; const bf16_t* pb0 = B0 + (size_t)r * K + 8 * kh; const bf16_t* pb1 = B1 + (size_t)r * K + 8 * kh;
#pragma unroll
    for (int n = 0; n < NB; ++n)
#pragma unroll
        for (int e = 0; e < 16; ++e) acc[n][e] = 0.f;
#pragma unroll 1
    for (int k = 0; k < K; k += 128) {
        sbf16x8 av[8], bv0[8], bv1[8];
#pragma unroll
        for (int j = 0; j < 8; ++j) { av[j] = *(const sbf16x8*)(pa + k + 16 * j); bv0[j] = *(const sbf16x8*)(pb0 + k + 16 * j); if (NB == 2) bv1[j] = *(const sbf16x8*)(pb1 + k + 16 * j); }
#pragma unroll
        for (int j = 0; j < 8; ++j) { acc[0] = __builtin_amdgcn_mfma_f32_32x32x16_bf16(av[j], bv0[j], acc[0], 0, 0, 0); if (NB == 2) acc[NB - 1] = __builtin_amdgcn_mfma_f32_32x32x16_bf16(av[j], bv1[j], acc[NB - 1], 0, 0, 0); }
    }
}
template <int KIND> __device__ __forceinline__ void ctx_gemm(ArgsP a, const bf16_t* A, const bf16_t* Bt, int K, int ncb, const float* gate, float gs, int tid) {
    const int lane = tid & 63, wave = tid >> 6, hi = lane >> 5, c = lane & 31;
    const int gw = blockIdx.x * NWAVES + wave, NGW = gridDim.x * NWAVES;
    unsigned char* ws = a->ws;
    for (int wt = gw; wt < 16 * ncb; wt += NGW) {
        const int cb = wt >> 4, rb = wt & 15; const int row0 = MLAT + 32 * rb;
        const bf16_t* Ar = A + (size_t)row0 * K;
        if (KIND == 0) {
            const int f0 = 32 * cb; const bf16_t* B0 = Bt + (size_t)(256 * (f0 >> 7) + (f0 & 127)) * K;
            sf32x16 acc[2]; wave_gemm32<2>(Ar, B0, B0 + (size_t)128 * K, K, lane, acc);
            bf16_t* H = (bf16_t*)(ws + WS_H);
#pragma unroll
            for (int r = 0; r < 16; ++r) { const float g = acc[0][r], up = acc[1][r]; H[(size_t)(row0 + crow32(r, hi)) * DFF + f0 + c] = (bf16_t)f2bf(g * __builtin_amdgcn_rcpf(1.f + __expf(-g)) * up); }
        } else if (KIND == 1) {
            const int col = 32 * cb + c; const bf16_t* B0 = Bt + (size_t)(32 * cb) * K;
            sf32x16 acc[1]; wave_gemm32<1>(Ar, B0, B0, K, lane, acc);
            float* X = (float*)(ws + WS_XC); const float gv = gs * gate[(size_t)2 * NMODV + col];
#pragma unroll
            for (int r = 0; r < 16; ++r) { float* p = X + (size_t)(32 * rb + crow32(r, hi)) * DM + col; *p = *p + gv * acc[0][r]; }
        } else if (KIND == 2) {
            const int col0 = 32 * cb; const bf16_t* B0 = Bt + (size_t)col0 * K;
            sf32x16 acc[1]; wave_gemm32<1>(Ar, B0, B0, K, lane, acc);
            bf16_t* O = col0 < 1024 ? (bf16_t*)(ws + WS_PA) + col0 + c : (bf16_t*)(ws + WS_PB) + (col0 - 1024) + c; const int ldc = col0 < 1024 ? 1024 : PBP;
#pragma unroll
            for (int r = 0; r < 16; ++r) O[(size_t)(row0 + crow32(r, hi)) * ldc] = (bf16_t)f2bf(acc[0][r]);
        } else {
            const int dir = cb >> 3, ch0 = (cb & 7) * 32, pn = dir * 2 + (ch0 >> 7); const bf16_t* B0 = Bt + (size_t)(256 * pn + (ch0 & 127)) * K;
            sf32x16 acc[2]; wave_gemm32<2>(Ar, B0, B0 + (size_t)128 * K, K, lane, acc);
            cf2* AB = (cf2*)(ws + WS_AB) + (size_t)dir * MTOT * 256 + ch0 + c;
#pragma unroll
            for (int r = 0; r < 16; ++r) AB[(size_t)(row0 + crow32(r, hi)) * 256] = mk2(acc[0][r], acc[1][r]);
        }
    }
}
#define XB_TMO      128
#define XB_XCNT(j)  (256  + 64 * (j))
#define XB_XSUB(j)  (1280 + 64 * (j))
#define XB_XGEN(j)  (2304 + 64 * (j))
#define XB_TOP      3328
#define XB_TOPGEN   3392
#define XCD_BAR_WORDS 3456
#define XB_SPIN_CAP (1u << 18)

__device__ __forceinline__ unsigned xb_ld(unsigned* p)              { return __hip_atomic_load(p, __ATOMIC_RELAXED, __HIP_MEMORY_SCOPE_AGENT); }
__device__ __forceinline__ unsigned xb_add(unsigned* p, unsigned v) { return __hip_atomic_fetch_add(p, v, __ATOMIC_RELAXED, __HIP_MEMORY_SCOPE_AGENT); }
__device__ __forceinline__ unsigned xb_xcc_id() { return (unsigned)__builtin_amdgcn_s_getreg((3 << 11) | 20) & 0xFu; }
#define XB_SPIN(cond, bar) do { unsigned _sp = 0; while (cond) { __builtin_amdgcn_s_sleep(1); \
    if ((++_sp & 255u) == 0u) { if (xb_ld(&(bar)[XB_TMO])) break; if (_sp > XB_SPIN_CAP) { atomicAdd(&(bar)[XB_TMO], 1u); break; } } } } while (0)

struct XcdBarrier {
    unsigned* bar; unsigned x;
    volatile LAS unsigned* st;
};

__device__ __forceinline__ XcdBarrier xcd_barrier_post(unsigned* bar, volatile LAS unsigned* st) {
    XcdBarrier b; b.bar = bar; b.x = xb_xcc_id(); b.st = st;
    if (threadIdx.x == 0) (void)xb_add(&bar[XB_XCNT(b.x)], 1u);
    return b;
}
__device__ __forceinline__ void xcd_barrier_complete(unsigned* bar, unsigned x, unsigned& nloc, unsigned& nx) {
    const unsigned G = gridDim.x * gridDim.y * gridDim.z;
    unsigned sum, cnt, mine, sp = 0u;
    for (;;) {
        sum = 0u; cnt = 0u; mine = 0u;
#pragma unroll
        for (unsigned j = 0; j < 16; ++j) { const unsigned c = xb_ld(&bar[XB_XCNT(j)]); sum += c; cnt += (c > 0u) ? 1u : 0u; mine = (j == x) ? c : mine; }
        if (sum == G) break;
        __builtin_amdgcn_s_sleep(1);
        if ((++sp & 255u) == 0u) { if (xb_ld(&bar[XB_TMO])) break; if (sp > XB_SPIN_CAP) { atomicAdd(&bar[XB_TMO], 1u); break; } }
    }
    nloc = mine > 0u ? mine : 1u; nx = cnt > 0u ? cnt : 1u;
}

__device__ __forceinline__ void xcd_barrier(const XcdBarrier& b) {
    asm volatile("s_waitcnt vmcnt(0)" ::: "memory");
    __syncthreads();
    if (threadIdx.x == 0) {
        unsigned* bar = b.bar;
        __builtin_amdgcn_s_waitcnt(0);
        unsigned nloc = b.st[0], nx = b.st[1];
        if (nloc == 0u) { xcd_barrier_complete(bar, b.x, nloc, nx); b.st[0] = nloc; b.st[1] = nx; }
        const unsigned old = xb_add(&bar[XB_XSUB(b.x)], 1u);
        const unsigned gen = old / nloc;
        if (old + 1u == (gen + 1u) * nloc) {
            __builtin_amdgcn_fence(__ATOMIC_RELEASE, "agent");
            asm volatile("s_waitcnt vmcnt(0)" ::: "memory");
            const unsigned og = xb_add(&bar[XB_TOP], 1u);
            const unsigned tg = og / nx;
            if (og + 1u == (tg + 1u) * nx) xb_add(&bar[XB_TOPGEN], 1u);
            else XB_SPIN(xb_ld(&bar[XB_TOPGEN]) == tg, bar);
            __builtin_amdgcn_fence(__ATOMIC_ACQUIRE, "agent");
            xb_add(&bar[XB_XGEN(b.x)], 1u);
            asm volatile("s_waitcnt vmcnt(0)" ::: "memory");
        } else {
            XB_SPIN(xb_ld(&bar[XB_XGEN(b.x)]) == gen, bar);
            __builtin_amdgcn_fence(__ATOMIC_ACQUIRE, "agent");
            asm volatile("s_waitcnt vmcnt(0)" ::: "memory");
        }
    }
    __syncthreads();
}
__device__ __forceinline__ void transpose_item(const float* W, int K, int N, bf16_t* WT, int k0, int n0, int drow0, LAS float* scr, int lane) {
#pragma unroll 8
    for (int i = 0; i < 32; ++i) { const int kk = 2 * i + (lane >> 5); scr[kk * 33 + (lane & 31)] = W[(size_t)(k0 + kk) * N + n0 + (lane & 31)]; }
    asm volatile("s_waitcnt lgkmcnt(0)" ::: "memory");
    const int c = lane & 7;
#pragma unroll
    for (int j = 0; j < 4; ++j) { const int n = (lane >> 3) + 8 * j; const LAS float* s = scr + (8 * c) * 33 + n;
        u32x4 o; o.x = pk2(s[0 * 33], s[1 * 33]); o.y = pk2(s[2 * 33], s[3 * 33]); o.z = pk2(s[4 * 33], s[5 * 33]); o.w = pk2(s[6 * 33], s[7 * 33]);
        *(u32x4*)(WT + (size_t)(drow0 + n) * K + k0 + 8 * c) = o; }
    asm volatile("s_waitcnt lgkmcnt(0)" ::: "memory");
}
__device__ __forceinline__ int w13_drow(int c) { return c < DFF ? 256 * (c >> 7) + (c & 127) : 256 * ((c - DFF) >> 7) + 128 + ((c - DFF) & 127); }

__device__ __forceinline__ void h2_row(ArgsP a, int l, int t, int n, float* dst, size_t dstride, int lane) {
    const float tt = (float)t / (float)(n - 1);
    const float w = (float)(2.0 * 3.14159265358979323846) * (float)t / (float)n;
    float z = 0.f;
    if (lane == 0) z = tt;
    else if (lane <= 16) { const float f = 1e-4f + (float)(lane - 1) * ((15.0f - 1e-4f) / 15.0f); z = cosf(f * w); }
    else if (lane <= 32) { const float f = 1e-4f + (float)(lane - 17) * ((15.0f - 1e-4f) / 15.0f); z = -sinf(f * w); }
    const float* w1 = a->in[I_HYW1] + (size_t)l * 33 * 64; const float* w2 = a->in[I_HYW2] + (size_t)l * 64 * 64;
    float h1 = a->in[I_HYB1][l * 64 + lane];
#pragma unroll
    for (int i = 0; i < 33; ++i) h1 += __shfl(z, i) * w1[i * 64 + lane];
    h1 = sinf(a->in[I_HYFREQ][(l * 2 + 0) * 64 + lane] * h1);
    float h2 = a->in[I_HYB2][l * 64 + lane];
#pragma unroll 8
    for (int i = 0; i < 64; ++i) h2 += __shfl(h1, i) * w2[i * 64 + lane];
    h2 = sinf(a->in[I_HYFREQ][(l * 2 + 1) * 64 + lane] * h2);
    dst[(size_t)lane * dstride] = h2;
}

__device__ __forceinline__ void prep_layer(ArgsP a, int l, LAS unsigned char* lds, int tid, int wave, int lane) {
    LAS float* scr = (LAS float*)(lds + wave * 16384);
    const int gw = blockIdx.x * NWAVES + wave, NGW = gridDim.x * NWAVES;
    unsigned char* ws = a->ws;
    constexpr int I13 = 16 * 176, I2 = 44 * 32, IIN = 16 * 72, IOUT = 16 * 32, NIT = 2 * I13 + 2 * I2 + IIN + IOUT;
    for (int it = gw; it < NIT; it += NGW) {
        int r = it;
        if (r < 2 * I13) { const int w = r / I13; r -= w * I13; const int kb = r / 176, nb = r % 176;
            transpose_item((w ? a->in[I_F2W13] : a->in[I_F1W13]) + (size_t)l * DM * 2 * DFF, DM, 2 * DFF, (bf16_t*)(ws + (w ? WS_W13B : WS_W13A)), 64 * kb, 32 * nb, w13_drow(32 * nb), scr, lane); continue; }
        r -= 2 * I13;
        if (r < 2 * I2) { const int w = r / I2; r -= w * I2; const int kb = r / 32, nb = r % 32;
            transpose_item((w ? a->in[I_F2W2] : a->in[I_F1W2]) + (size_t)l * DFF * DM, DFF, DM, (bf16_t*)(ws + (w ? WS_W2B : WS_W2A)), 64 * kb, 32 * nb, 32 * nb, scr, lane); continue; }
        r -= 2 * I2;
        if (r < IIN) { const int kb = r / 72, nb = r % 72; transpose_item(a->in[I_WIN] + (size_t)l * DM * DIN, DM, DIN, (bf16_t*)(ws + WS_WIN), 64 * kb, 32 * nb, 32 * nb, scr, lane); continue; }
        r -= IIN;
        { const int kb = r / 32, nb = r % 32; transpose_item(a->in[I_WOUT] + (size_t)l * DM * DM, DM, DM, (bf16_t*)(ws + WS_WOUT), 64 * kb, 32 * nb, 32 * nb, scr, lane); }
    }
    {
        bf16_t* WL = (bf16_t*)(ws + WS_WLRU);
        const int gt = blockIdx.x * NTHREADS + tid, NGT = gridDim.x * NTHREADS;
        for (int idx = gt; idx < 1024 * 32; idx += NGT) {
            const int np = idx >> 5, k0 = (idx & 31) * 8; const int pn = np >> 8, j = np & 255, dir = pn >> 1, mat = j >> 7, ch = (pn & 1) * 128 + (j & 127), blk = ch >> 6, e = ch & 63;
            float v[8];
            const float* src = (mat ? a->in[I_LRUWX] : a->in[I_LRUWA]) + ((((size_t)l * 2 + dir) * 4 + blk) * 64) * 64 + e;
#pragma unroll
            for (int i = 0; i < 8; ++i) { const int k = k0 + i; v[i] = ((k >> 6) == blk) ? src[(size_t)(k & 63) * 64] : 0.f; }
            *(u32x4*)(WL + (size_t)np * 256 + k0) = pack8(v);
        }
    }
    {
        float* H2 = (float*)(ws + WS_H2); float* H2C = (float*)(ws + WS_H2C);
        for (int t = gw; t < SEQ + CTXL; t += NGW) { if (t < SEQ) h2_row(a, l, t, SEQ, H2 + t, SEQ, lane); else h2_row(a, l, t - SEQ, CTXL, H2C + (size_t)(t - SEQ) * 64, 1, lane); }
    }
}

__device__ __forceinline__ void norm_phase(ArgsP a, int l, int k, int wave, int lane, int nsplit = 0, bool from_input = false) {
    const int gw = blockIdx.x * NWAVES + wave, NGW = gridDim.x * NWAVES;
    const float* g = a->in[I_NORMG] + ((size_t)l * 3 + k) * DM; const float* MOD = (const float*)(a->ws + WS_MOD) + (size_t)l * 3 * NMODV;
    bf16_t* XN = (bf16_t*)(a->ws + WS_XN);
    f32x4 gv[4];
#pragma unroll
    for (int j = 0; j < 4; ++j) gv[j] = *(const f32x4*)(g + 4 * lane + 256 * j);
    for (int row = gw; row < MTOT; row += NGW) {
        const float* xr = (from_input && row < MLAT) ? a->in[I_X] + (size_t)row * DM : xrow_ptr(a, row); const int mi = mod_index(row);
        const float* sh = MOD + (size_t)mi * NMODV + (3 * k) * DM; const float* sc = sh + DM;
        f32x4 v[4]; float s = 0.f;
#pragma unroll
        for (int j = 0; j < 4; ++j) v[j] = *(const f32x4*)(xr + 4 * lane + 256 * j);
        if (nsplit > 0 && row >= MLAT) {
            const float* pp = (const float*)(a->ws + WS_PART) + (size_t)(row - MLAT) * DM + 4 * lane;
            for (int ks = 0; ks < nsplit; ++ks) {
#pragma unroll
                for (int j = 0; j < 4; ++j) v[j] = v[j] + *(const f32x4*)(pp + (size_t)ks * (NBATCH * CTXL) * DM + 256 * j);
            }
            float* xw = (float*)xr;
#pragma unroll
            for (int j = 0; j < 4; ++j) *(f32x4*)(xw + 4 * lane + 256 * j) = v[j];
        }
#pragma unroll
        for (int j = 0; j < 4; ++j) s += (v[j].x * v[j].x + v[j].y * v[j].y) + (v[j].z * v[j].z + v[j].w * v[j].w);
        const float rs = rsqrtf(wave_sum(s) * (1.f / DM) + EPSF);
#pragma unroll
        for (int j = 0; j < 4; ++j) {
            const f32x4 scv = *(const f32x4*)(sc + 4 * lane + 256 * j), shv = *(const f32x4*)(sh + 4 * lane + 256 * j);
            const f32x4 y = v[j] * rs * gv[j] * (scv + 1.f) + shv;
            u32x2 o; o.x = pk2(y.x, y.y); o.y = pk2(y.z, y.w);
            *(u32x2*)(XN + (size_t)row * DM + 4 * lane + 256 * j) = o;
        }
    }
}
__device__ __forceinline__ void final_norm_phase(ArgsP a, int wave, int lane) {
    const int gw = blockIdx.x * NWAVES + wave, NGW = gridDim.x * NWAVES;
    const float* g = a->in[I_FINALG];
    for (int row = gw; row < MLAT; row += NGW) {
        float* xr = a->out + (size_t)row * DM;
        f32x4 v[4]; float s = 0.f;
#pragma unroll
        for (int j = 0; j < 4; ++j) { v[j] = *(const f32x4*)(xr + 4 * lane + 256 * j); s += (v[j].x * v[j].x + v[j].y * v[j].y) + (v[j].z * v[j].z + v[j].w * v[j].w); }
        const float rs = rsqrtf(wave_sum(s) * (1.f / DM) + EPSF);
#pragma unroll
        for (int j = 0; j < 4; ++j) *(f32x4*)(xr + 4 * lane + 256 * j) = v[j] * rs * *(const f32x4*)(g + 4 * lane + 256 * j);
    }
}

__device__ __forceinline__ void prologue_phase(ArgsP a, LAS unsigned char* lds, int tid, int wave, int lane) {
    const int gt = blockIdx.x * NTHREADS + tid, NGT = gridDim.x * NTHREADS;
    cf2* T14 = (cf2*)(a->ws + WS_TW14); cf2* T15 = (cf2*)(a->ws + WS_TW15);
    for (int k = gt; k < 16384; k += NGT) { float s, c; sincospif((float)k * (1.0f / 8192.0f), &s, &c); T14[k] = mk2(c, -s); sincospif((float)k * (1.0f / 16384.0f), &s, &c); T15[k] = mk2(c, -s); }
    { const f32x4* src = (const f32x4*)a->in[I_CTX]; f32x4* dst = (f32x4*)(a->ws + WS_XC); for (int i = gt; i < NBATCH * CTXL * DM / 4; i += NGT) dst[i] = src[i]; }
    LAS float* sc = (LAS float*)lds; LAS float* part = sc + 3 * DM;
    for (int i = tid; i < 3 * DM; i += NTHREADS) { const int mi = i >> 10, k = i & 1023; const float c = mi < 2 ? a->in[I_C][mi * DM + k] : a->in[I_CCTX][k]; sc[i] = c / (1.f + expf(-c)); }
    __syncthreads();
    float* MOD = (float*)(a->ws + WS_MOD);
    for (int u = blockIdx.x; u < DEPTH * 36; u += gridDim.x) {
        const int l = u / 36, n = (u % 36) * 256 + (tid & 255), kh = tid >> 8;
        const float* w = a->in[I_WMOD] + ((size_t)l * DM + kh * 512) * NMODV + n;
        float a0 = 0.f, a1 = 0.f, a2 = 0.f;
#pragma unroll 8
        for (int k = 0; k < 512; ++k) { const float wv = w[(size_t)k * NMODV]; a0 += sc[kh * 512 + k] * wv; a1 += sc[DM + kh * 512 + k] * wv; a2 += sc[2 * DM + kh * 512 + k] * wv; }
        if (kh == 1) { part[tid & 255] = a0; part[256 + (tid & 255)] = a1; part[512 + (tid & 255)] = a2; }
        __syncthreads();
        if (kh == 0) { const float b = a->in[I_BMOD][l * NMODV + n];
            MOD[((size_t)l * 3 + 0) * NMODV + n] = a0 + part[tid] + b; MOD[((size_t)l * 3 + 1) * NMODV + n] = a1 + part[256 + tid] + b; MOD[((size_t)l * 3 + 2) * NMODV + n] = a2 + part[512 + tid] + b; }
        __syncthreads();
    }
}

__device__ __forceinline__ void e1_phase(ArgsP a, int l, LAS unsigned char* lds, int tid, int wave, int lane) {
    const int gw = blockIdx.x * NWAVES + wave, NGW = gridDim.x * NWAVES;
    const int gt = blockIdx.x * NTHREADS + tid, NGT = gridDim.x * NTHREADS;
    bf16_t* PB = (bf16_t*)(a->ws + WS_PB); const bf16_t* PA = (const bf16_t*)(a->ws + WS_PA); bf16_t* R = (bf16_t*)(a->ws + WS_R); float* UT = (float*)(a->ws + WS_UT);
    {
        const float* gain = a->in[I_QKGAIN] + l * 128;
        const int p = lane & 31, hw = lane >> 5;
        const float invf = exp2f(-(float)(p & 15) * (13.287712379549449f / 16.f));
        const float g0a = gain[p], g0b = gain[32 + p], g1a = gain[64 + p], g1b = gain[96 + p];
        for (int row = gw; row < MTOT; row += NGW) {
            float cs = 1.f, sn = 0.f;
            if (row < MLAT) { const int t = row & (SEQ - 1); const float pos = (p < 16) ? (float)(t >> 6) : (float)(t & 63); sincosf(pos * invf, &sn, &cs); }
            bf16_t* pr = PB + (size_t)row * PBP;
#pragma unroll
            for (int i = 0; i < 6; ++i) {
                const int hd = 2 * i + hw; const int col = hd < 6 ? 256 + 64 * hd : 768 + 64 * (hd - 6);
                float z1 = bf2f(pr[col + p]), z2 = bf2f(pr[col + 32 + p]);
                if (i >= 3) {
                    float ss = z1 * z1 + z2 * z2;
#pragma unroll
                    for (int o = 1; o < 32; o <<= 1) ss += __shfl_xor(ss, o);
                    const float r = rsqrtf(ss * (1.f / 64.f) + EPSF);
                    z1 *= r * (i >= 5 ? g1a : g0a); z2 *= r * (i >= 5 ? g1b : g0b);
                }
                float o1 = z1 * cs - z2 * sn, o2 = z1 * sn + z2 * cs;
                if (i < 2 || i == 3 || i == 4) { o1 *= QC2; o2 *= QC2; }
                pr[col + p] = (bf16_t)f2bf(o1); pr[col + 32 + p] = (bf16_t)f2bf(o2);
            }
        }
    }
    {
        const float* cw = a->in[I_LRUCW] + (size_t)l * 4 * 256; const float* cb = a->in[I_LRUCB] + (size_t)l * 256;
        for (int idx = gt; idx < MTOT * 32; idx += NGT) {
            const int row = idx >> 5, ch0 = (idx & 31) * 8; const bool lat = row < MLAT; const int pos = lat ? (row & (SEQ - 1)) : ((row - MLAT) & (CTXL - 1)); const int len = lat ? SEQ : CTXL;
            float acc[8];
#pragma unroll
            for (int i = 0; i < 8; ++i) acc[i] = cb[ch0 + i];
#pragma unroll
            for (int k = 0; k < 4; ++k) { const int pp = pos + k - 2; if (pp >= 0 && pp < len) { float v[8]; unpack8(*(const u32x4*)(PA + (size_t)(row + k - 2) * 1024 + 768 + ch0), v);
#pragma unroll
                for (int i = 0; i < 8; ++i) acc[i] += cw[k * 256 + ch0 + i] * v[i]; } }
            *(u32x4*)(R + (size_t)row * 256 + ch0) = pack8(acc);
        }
    }
    {
        const float* cw = a->in[I_HYCW] + (size_t)l * 3 * 768; const float* cb = a->in[I_HYCB] + (size_t)l * 768; float* UC = (float*)(a->ws + WS_UC);
        for (int idx = gt; idx < NBATCH * CTXL * 768; idx += NGT) {
            const int c = idx % 768, bt = idx / 768, t = bt & (CTXL - 1), b = bt >> 8; const size_t row = (size_t)MLAT + bt;
            float acc = cb[c];
#pragma unroll
            for (int k = 0; k < 3; ++k) { const int tt = t + k - 1; if (tt >= 0 && tt < CTXL) acc += cw[k * 768 + c] * bf2f(PA[(row + k - 1) * 1024 + c]); }
            const int p = c >> 8, ch = c & 255;
            UC[((size_t)(p * 2 + b) * 256 + ch) * 256 + t] = acc;
        }
    }
    {
        const float* cw = a->in[I_HYCW] + (size_t)l * 3 * 768; const float* cb = a->in[I_HYCB] + (size_t)l * 768;
        LAS float* T = (LAS float*)lds; const int cgp = tid & 31, tr = tid >> 5;
        for (int u = blockIdx.x; u < 512 * 3; u += gridDim.x) {
            const int tile = u / 3, plane = u % 3, b = tile >> 8, t0 = (tile & 255) * 64; const int cc = plane * 256 + 8 * cgp;
            float wk[3][8], bb[8];
#pragma unroll
            for (int i = 0; i < 8; ++i) { bb[i] = cb[cc + i]; wk[0][i] = cw[cc + i]; wk[1][i] = cw[768 + cc + i]; wk[2][i] = cw[1536 + cc + i]; }
#pragma unroll
            for (int it = 0; it < 4; ++it) {
                const int tl = tr + 16 * it, t = t0 + tl; const size_t row = (size_t)b * SEQ + t;
                float acc[8];
#pragma unroll
                for (int i = 0; i < 8; ++i) acc[i] = bb[i];
#pragma unroll
                for (int k = 0; k < 3; ++k) { const int tt = t + k - 1; if (tt >= 0 && tt < SEQ) { float v[8]; unpack8(*(const u32x4*)(PA + (row + k - 1) * 1024 + cc), v);
#pragma unroll
                    for (int i = 0; i < 8; ++i) acc[i] += wk[k][i] * v[i]; } }
#pragma unroll
                for (int i = 0; i < 8; ++i) T[(8 * cgp + i) * 65 + tl] = acc[i];
            }
            __syncthreads();
            if (plane == 0) { for (int c = wave; c < 256; c += NWAVES) UT[((size_t)b * 256 + c) * SEQ + t0 + lane] = T[c * 65 + lane]; }
            else {
                bf16_t* UTB = (bf16_t*)(UT + (size_t)2 * 256 * SEQ);
                for (int c = wave; c < 256; c += NWAVES) UTB[((size_t)((plane - 1) * 2 + b) * 256 + c) * SEQ + t0 + lane] = (bf16_t)f2bf(T[c * 65 + lane]);
            }
            __syncthreads();
        }
    }
}

__device__ __forceinline__ void e2_phase(ArgsP a, LAS unsigned char* lds, int tid, int wave, int lane) {
    const int gt = blockIdx.x * NTHREADS + tid, NGT = gridDim.x * NTHREADS;
    const bf16_t* PB = (const bf16_t*)(a->ws + WS_PB); const float* UT = (const float*)(a->ws + WS_UT); bf16_t* Y = (bf16_t*)(a->ws + WS_XN); const cf2* AB = (const cf2*)(a->ws + WS_AB);
    LAS float* T = (LAS float*)lds; const int cgp = tid & 31, tr = tid >> 5;
    for (int u = blockIdx.x; u < 512; u += gridDim.x) {
        const int b = u >> 8, t0 = (u & 255) * 64;
        for (int c = wave; c < 256; c += NWAVES) T[c * 65 + lane] = UT[((size_t)b * 256 + c) * SEQ + t0 + lane];
        __syncthreads();
#pragma unroll
        for (int it = 0; it < 4; ++it) { const int tl = tr + 16 * it; float v[8];
#pragma unroll
            for (int i = 0; i < 8; ++i) v[i] = T[(8 * cgp + i) * 65 + tl];
            *(u32x4*)(Y + ((size_t)b * SEQ + t0 + tl) * DM + 8 * cgp) = pack8(v); }
        __syncthreads();
    }
    const float* CAR = (const float*)(a->ws + WS_CAR);
    for (int idx = gt; idx < MTOT * 32; idx += NGT) {
        const int row = idx >> 5, ch0 = (idx & 31) * 8;
        float g[8]; unpack8(*(const u32x4*)(PB + (size_t)row * PBP + ch0), g);
        const unsigned* h0p = (const unsigned*)AB + (size_t)row * 256 + ch0; const unsigned* h1p = (const unsigned*)AB + ((size_t)MTOT + row) * 256 + ch0;
        const u32x4 q0a = *(const u32x4*)h0p, q0b = *(const u32x4*)(h0p + 4), q1a = *(const u32x4*)h1p, q1b = *(const u32x4*)(h1p + 4);
        const unsigned h0[8] = {q0a.x, q0a.y, q0a.z, q0a.w, q0b.x, q0b.y, q0b.z, q0b.w}, h1[8] = {q1a.x, q1a.y, q1a.z, q1a.w, q1b.x, q1b.y, q1b.z, q1b.w};
        int b, p0, p1;
        if (row < MLAT) { b = row >> 14; const int t = row & (SEQ - 1); p0 = CTXL + t; p1 = CTXL + (SEQ - 1 - t); }
        else { b = (row - MLAT) >> 8; const int j = (row - MLAT) & (CTXL - 1); p0 = j; p1 = CTXL - 1 - j; }
        const float* c0 = CAR + ((size_t)((0 * 2 + b) * NCH + p0 / LCH)) * 256 + ch0; const float* c1 = CAR + ((size_t)((1 * 2 + b) * NCH + p1 / LCH)) * 256 + ch0;
        float v[8];
#pragma unroll
        for (int i = 0; i < 8; ++i) { const float x = g[i]; const float uu = 0.7978845608028654f * (x + 0.044715f * x * x * x); const float th = 1.f - 2.f / (__expf(2.f * uu) + 1.f);
            v[i] = 0.5f * x * (1.f + th) * ((bfhi(h0[i]) + bflo(h0[i]) * c0[i]) + (bfhi(h1[i]) + bflo(h1[i]) * c1[i])); }
        *(u32x4*)(Y + (size_t)row * DM + 256 + ch0) = pack8(v);
    }
}
__device__ __forceinline__ cf2 cmul(cf2 a, cf2 b) { return mk2(a.x * b.x - a.y * b.y, a.x * b.y + a.y * b.x); }
__device__ __forceinline__ cf2 cmulc(cf2 a, cf2 b) { return mk2(a.x * b.x + a.y * b.y, a.y * b.x - a.x * b.y); }
constexpr int FN = 16384;
__device__ __forceinline__ void fft_fwd(LAS cf2* C, const cf2* __restrict__ TW, int tid) {
    for (int lh = 13; lh >= 0; --lh) {
        const int h = 1 << lh;
#pragma unroll 4
        for (int i = tid; i < FN / 2; i += NTHREADS) {
            const int j = i & (h - 1), p0 = ((i >> lh) << (lh + 1)) + j, p1 = p0 + h;
            const cf2 x = C[p0], y = C[p1], w = TW[j << (13 - lh)];
            C[p0] = mk2(x.x + y.x, x.y + y.y);
            C[p1] = cmul(mk2(x.x - y.x, x.y - y.y), w);
        }
        __syncthreads();
    }
}
__device__ __forceinline__ void fft_inv(LAS cf2* C, const cf2* __restrict__ TW, int tid) {
    for (int lh = 0; lh <= 13; ++lh) {
        const int h = 1 << lh;
#pragma unroll 4
        for (int i = tid; i < FN / 2; i += NTHREADS) {
            const int j = i & (h - 1), p0 = ((i >> lh) << (lh + 1)) + j, p1 = p0 + h;
            const cf2 x = C[p0], y = cmulc(C[p1], TW[j << (13 - lh)]);
            C[p0] = mk2(x.x + y.x, x.y + y.y);
            C[p1] = mk2(x.x - y.x, x.y - y.y);
        }
        __syncthreads();
    }
}
__device__ __forceinline__ float block_sum(float v, LAS float* red, int tid, int wave, int lane) {
    v = wave_sum(v);
    __syncthreads();
    if (lane == 0) red[wave] = v;
    __syncthreads();
    float t = 0.f;
#pragma unroll
    for (int i = 0; i < NWAVES; ++i) t += red[i];
    return t;
}
constexpr float HY_MIN_DECAY = -3.0701134573253946f, HY_MAX_DECAY = -15.350567286626973f;

constexpr int CPAD = 17920;
#define PH(p) ((p) + ((p) >> 4) + (((p) >> 9) << 4))
struct TwC { float c[9]; };
__device__ __forceinline__ TwC make_twc() {
    TwC t; t.c[0] = 1.f; t.c[1] = 0.980785280f; t.c[2] = 0.923879533f; t.c[3] = 0.831469612f; t.c[4] = 0.707106781f; t.c[5] = 0.555570233f; t.c[6] = 0.382683432f; t.c[7] = 0.195090322f; t.c[8] = 0.f;
#pragma unroll
    for (int k = 1; k < 8; ++k) asm volatile("" : "+v"(t.c[k]));
    return t;
}
#define TWC_COS(W, m) ((m) <= 8 ? (W).c[(m)] : -(W).c[16 - (m)])
#define TWC_SIN(W, m) ((m) <= 8 ? (W).c[8 - (m)] : (W).c[(m) - 8])
template <int R, bool HASB> __device__ __forceinline__ void dif_regs(cf2 (&x)[R], const TwC& W, const cf2 (&B)[5]) {
    constexpr int LOGR = (R == 32) ? 5 : 4;
#pragma unroll
    for (int st = 0; st < LOGR; ++st) {
        const int d = (R / 2) >> st;
#pragma unroll
        for (int i = 0; i < R; ++i) if ((i & d) == 0) {
            const int m = (i & (d - 1)) * (16 / d);
            const cf2 a = x[i], b = x[i + d];
            x[i] = mk2(a.x + b.x, a.y + b.y); float tx = a.x - b.x, ty = a.y - b.y;
            if (m == 8) { const float u = tx; tx = ty; ty = -u; }
            else if (m != 0) { const float c = TWC_COS(W, m), s = TWC_SIN(W, m); const float u = tx * c + ty * s; ty = ty * c - tx * s; tx = u; }
            if (HASB) { const float u = tx * B[st].x - ty * B[st].y; ty = tx * B[st].y + ty * B[st].x; tx = u; }
            x[i + d] = mk2(tx, ty);
        }
        __builtin_amdgcn_sched_barrier(0);
    }
}
template <int R, bool HASB> __device__ __forceinline__ void dit_regs(cf2 (&x)[R], const TwC& W, const cf2 (&B)[5]) {
    constexpr int LOGR = (R == 32) ? 5 : 4;
#pragma unroll
    for (int st = LOGR - 1; st >= 0; --st) {
        const int d = (R / 2) >> st;
#pragma unroll
        for (int i = 0; i < R; ++i) if ((i & d) == 0) {
            const int m = (i & (d - 1)) * (16 / d);
            const cf2 a = x[i], b = x[i + d]; float bx = b.x, by = b.y;
            if (HASB) { const float u = bx * B[st].x + by * B[st].y; by = by * B[st].x - bx * B[st].y; bx = u; }
            if (m == 8) { const float u = bx; bx = -by; by = u; }
            else if (m != 0) { const float c = TWC_COS(W, m), s = TWC_SIN(W, m); const float u = bx * c - by * s; by = by * c + bx * s; bx = u; }
            x[i] = mk2(a.x + bx, a.y + by); x[i + d] = mk2(a.x - bx, a.y - by);
        }
        __builtin_amdgcn_sched_barrier(0);
    }
}
struct FftCtx { LAS cf2* C; const cf2* T14; int tid; };
template <bool INV> __device__ __forceinline__ void pass1(const FftCtx& F_) {
    FftCtx F = F_; asm volatile("" : "+v"(F.tid)); const TwC W = make_twc();
    cf2 x[32], B[5];
#pragma unroll
    for (int s = 0; s < 5; ++s) B[s] = F.T14[F.tid << s];
#pragma unroll
    for (int i = 0; i < 32; ++i) x[i] = F.C[PH(512 * i + F.tid)];
    __builtin_amdgcn_sched_barrier(0);
    if (INV) dit_regs<32, true>(x, W, B); else dif_regs<32, true>(x, W, B);
#pragma unroll
    for (int i = 0; i < 32; ++i) F.C[PH(512 * i + F.tid)] = x[i];
}
template <bool INV> __device__ __forceinline__ void pass2(const FftCtx& F_) {
    FftCtx F = F_; asm volatile("" : "+v"(F.tid)); const TwC W = make_twc();
    const int blk = F.tid >> 4, q = F.tid & 15;
    cf2 x[32], B[5];
#pragma unroll
    for (int s = 0; s < 5; ++s) B[s] = F.T14[q << (5 + s)];
#pragma unroll
    for (int i = 0; i < 32; ++i) x[i] = F.C[PH(512 * blk + q + 16 * i)];
    __builtin_amdgcn_sched_barrier(0);
    if (INV) dit_regs<32, true>(x, W, B); else dif_regs<32, true>(x, W, B);
#pragma unroll
    for (int i = 0; i < 32; ++i) F.C[PH(512 * blk + q + 16 * i)] = x[i];
}
template <int MODE> __device__ __forceinline__ void pass3(const FftCtx& F_, cf2* K) {
    FftCtx F = F_; asm volatile("" : "+v"(F.tid)); const TwC W = make_twc();
    cf2 B[5];
#pragma unroll
    for (int s = 0; s < 5; ++s) B[s] = mk2(1.f, 0.f);
#pragma unroll
    for (int g = 0; g < 2; ++g) {
        const int base = 16 * (F.tid + 512 * g); cf2 y[16];
#pragma unroll
        for (int i = 0; i < 16; ++i) y[i] = F.C[PH(base + i)];
        __builtin_amdgcn_sched_barrier(0);
        dif_regs<16, false>(y, W, B);
        if (MODE == 0) {
#pragma unroll
            for (int r = 0; r < 16; ++r) (K + (g * 16 + r) * 512)[F.tid] = y[r];
        } else {
#pragma unroll
            for (int r = 0; r < 16; ++r) { y[r] = cmul(y[r], (K + (g * 16 + r) * 512)[F.tid]); if ((r & 7) == 7) __builtin_amdgcn_sched_barrier(0); }
            dit_regs<16, false>(y, W, B);
#pragma unroll
            for (int i = 0; i < 16; ++i) F.C[PH(base + i)] = y[i];
        }
        __builtin_amdgcn_sched_barrier(0);
    }
}
__device__ __forceinline__ void fft_to_spectrum(const FftCtx& F, cf2* K) {
    pass1<false>(F); __syncthreads(); pass2<false>(F); __syncthreads(); pass3<0>(F, K); __syncthreads();
}
__device__ __forceinline__ void fft_conv(const FftCtx& F, cf2* K) {
    pass1<false>(F); __syncthreads(); pass2<false>(F); __syncthreads(); pass3<1>(F, K); __syncthreads(); pass2<true>(F); __syncthreads(); pass1<true>(F); __syncthreads();
}

#define LTID int tl = tid; asm volatile("" : "+v"(tl));
__device__ __forceinline__ void hyena_unit2(ArgsP a, int l, int ch, LAS unsigned char* lds, int tid, int wave, int lane, const int DRY) {
    LAS cf2* C = (LAS cf2*)lds;
    LAS float* red = (LAS float*)(lds + CPAD * 8); LAS float* wcol = red + 16;
    const cf2* T15 = (const cf2*)(a->ws + WS_TW15);
    FftCtx F; F.C = C; F.T14 = (const cf2*)(a->ws + WS_TW14); F.tid = tid;
    const float* H2T = (const float*)(a->ws + WS_H2);
    cf2* KE = (cf2*)(a->ws + WS_KF + (size_t)blockIdx.x * 262144); cf2* KO = KE + FN;
    float* UT = (float*)(a->ws + WS_UT);
    float* v0 = UT + ((size_t)(0 * 2 + 0) * 256 + ch) * SEQ; float* v1 = UT + ((size_t)(0 * 2 + 1) * 256 + ch) * SEQ;
    const float delta = fabsf(HY_MIN_DECAY + (float)ch * ((HY_MAX_DECAY - HY_MIN_DECAY) / 255.0f));
#pragma unroll 1
    for (int o = 0; o < 2; ++o) {
        const float* w3 = a->in[I_HYW3] + (size_t)l * 64 * 1024 + o * 512 + ch;
        __syncthreads();
        { LTID if (tl < 128) wcol[tl] = w3[(size_t)(tl & 63) * 1024 + (tl >> 6) * 256]; }
        __syncthreads();
        float asum = 0.f;
        {   LTID const LAS f32x4* wc4 = (const LAS f32x4*)wcol; asm volatile("" : "+v"(wc4));
#pragma unroll 1
            for (int i0 = 0; i0 < 32; i0 += 4) {
                const float* hc = H2T + tl + NTHREADS * i0;
                float f[4] = {0.f, 0.f, 0.f, 0.f}, bk[4] = {0.f, 0.f, 0.f, 0.f};
#pragma unroll
                for (int j4 = 0; j4 < 16; ++j4) {
                    const f32x4 wf = wc4[j4], wb = wc4[16 + j4];
#pragma unroll
                    for (int jj = 0; jj < 4; ++jj) {
#pragma unroll
                        for (int e = 0; e < 4; ++e) { const float hv = hc[(size_t)(4 * j4 + jj) * SEQ + NTHREADS * e]; f[e] += hv * wf[jj]; bk[e] += hv * wb[jj]; }
                    }
                }
#pragma unroll
                for (int e = 0; e < 4; ++e) {
                    const int t = tl + NTHREADS * (i0 + e);
                    const float dec = expf(-((float)t * (1.0f / (float)(SEQ - 1))) * delta);
                    const float fv = f[e] * dec, bv = bk[e] * dec; asum += fabsf(fv) + fabsf(bv);
                    C[PH(t)] = mk2(fv, bv);
                }
            }
        }
        const float tot = block_sum(asum, red, tid, wave, lane);
        const float scale = 1.0f / ((tot + EPSF) * (float)(2 * FN));
        { LTID
#pragma unroll 16
        for (int i = 0; i < 32; ++i) {
            const int t = tl + NTHREADS * i;
            const float fw = C[PH(t)].x, bw = (t > 0) ? C[PH(FN - t)].y : 0.f;
            const float d = (fw - bw) * scale; const cf2 w = T15[t];
            KE[t] = mk2((fw + bw) * scale, 0.f); KO[t] = mk2(d * w.x, d * w.y);
        } }
        __syncthreads();
        { LTID
#pragma unroll 16
        for (int i = 0; i < 32; ++i) { const int t = tl + NTHREADS * i; C[PH(t)] = KE[t]; } }
        __syncthreads();
        fft_to_spectrum(F, KE);
        { LTID
#pragma unroll 16
        for (int i = 0; i < 32; ++i) { const int t = tl + NTHREADS * i; C[PH(t)] = KO[t]; } }
        __syncthreads();
        fft_to_spectrum(F, KO);
        { LTID
#pragma unroll 16
        for (int i = 0; i < 32; ++i) { const int t = tl + NTHREADS * i; C[PH(t)] = mk2(v0[t], v1[t]); } }
        __syncthreads();
        fft_conv(F, KE);
        { LTID
#pragma unroll 16
        for (int i = 0; i < 32; ++i) { const int t = tl + NTHREADS * i; KE[t] = C[PH(t)]; } }
        __syncthreads();
        { LTID
#pragma unroll 16
        for (int i = 0; i < 32; ++i) { const int t = tl + NTHREADS * i; C[PH(t)] = cmul(mk2(v0[t], v1[t]), T15[t]); } }
        __syncthreads();
        fft_conv(F, KO);
        const float sk = a->in[I_HYSKIP][((size_t)l * 2 + o) * 256 + ch];
        const bf16_t* UTB = (const bf16_t*)(UT + (size_t)2 * 256 * SEQ);
        const bf16_t* m0 = UTB + ((size_t)(o * 2 + 0) * 256 + ch) * SEQ; const bf16_t* m1 = UTB + ((size_t)(o * 2 + 1) * 256 + ch) * SEQ;
        { LTID
#pragma unroll 8
        for (int i = 0; i < 32; ++i) {
            const int t = tl + NTHREADS * i;
            const cf2 bq = cmulc(C[PH(t)], T15[t]); const cf2 av = KE[t];
            const float x0 = v0[t], x1 = v1[t];
            const float y0 = av.x + bq.x + sk * x0, y1 = av.y + bq.y + sk * x1;
            v0[t] = bf2f(m0[t]) * y0; v1[t] = bf2f(m1[t]) * y1;
        } }
        __syncthreads();
    }
}

__device__ __forceinline__ void hyena_ctx_unit(ArgsP a, int l, int ch, LAS unsigned char* lds, int tid, int wave, int lane) {
    LAS float* F = (LAS float*)lds;
    LAS float* U = F + 1024;
    LAS float* Z = U + 1536;
    LAS float* red = Z + 512;
    const float* H2C = (const float*)(a->ws + WS_H2C); bf16_t* Y = (bf16_t*)(a->ws + WS_XN);
    const float delta = fabsf(HY_MIN_DECAY + (float)ch * ((HY_MAX_DECAY - HY_MIN_DECAY) / 255.0f));
    __syncthreads();
    {
        const int o = tid >> 8, t = tid & 255; const float* w3 = a->in[I_HYW3] + (size_t)l * 64 * 1024 + o * 512 + ch; const float* hr = H2C + t * 64;
        float f = 0.f, bk = 0.f;
#pragma unroll 8
        for (int j = 0; j < 64; ++j) { const float hv = hr[j]; f += hv * w3[(size_t)j * 1024]; bk += hv * w3[(size_t)j * 1024 + 256]; }
        const float dec = expf(-((float)t * (1.0f / 255.0f)) * delta); f *= dec; bk *= dec;
        float s = wave_sum(fabsf(f) + fabsf(bk));
        if (lane == 0) red[wave] = s;
        __syncthreads();
        const float tot = (red[4 * o] + red[4 * o + 1]) + (red[4 * o + 2] + red[4 * o + 3]);
        const float sc = 1.f / (tot + EPSF);
        F[(o * 2 + 0) * 256 + t] = f * sc; F[(o * 2 + 1) * 256 + t] = bk * sc;
    }
    {
        const int b = tid >> 8, t = tid & 255; const float* UC = (const float*)(a->ws + WS_UC);
#pragma unroll
        for (int p = 0; p < 3; ++p) U[(p * 2 + b) * 256 + t] = UC[((size_t)(p * 2 + b) * 256 + ch) * 256 + t];
    }
    __syncthreads();
    const int b = tid >> 8, t = tid & 255;
    {
        const LAS float* fw = F, *bw = F + 256; const LAS float* x = U + b * 256; float y = 0.f;
        for (int s = 0; s <= t; ++s) y += fw[t - s] * x[s];
        for (int s = t + 1; s < CTXL; ++s) y += bw[s - t] * x[s];
        y += a->in[I_HYSKIP][((size_t)l * 2 + 0) * 256 + ch] * x[t];
        Z[b * 256 + t] = U[(2 + b) * 256 + t] * y;
    }
    __syncthreads();
    {
        const LAS float* fw = F + 512, *bw = F + 768; const LAS float* x = Z + b * 256; float y = 0.f;
        for (int s = 0; s <= t; ++s) y += fw[t - s] * x[s];
        for (int s = t + 1; s < CTXL; ++s) y += bw[s - t] * x[s];
        y += a->in[I_HYSKIP][((size_t)l * 2 + 1) * 256 + ch] * x[t];
        Y[((size_t)MLAT + b * CTXL + t) * DM + ch] = (bf16_t)f2bf(U[(4 + b) * 256 + t] * y);
    }
    __syncthreads();
}

#define MIX_TID int tid = threadIdx.x; asm volatile("" : "+v"(tid)); const int lane = tid & 63, wave = __builtin_amdgcn_readfirstlane(tid >> 6); (void)lane; (void)wave;
__device__ __forceinline__ void mix_phase(int l, LAS unsigned char* lds, char* lds_generic) {
    using attn_body::AttnJob; typedef attn_body::bf16 abf;
    const int G = gridDim.x, bx = blockIdx.x;
#ifndef NO_HY
    for (int u = bx; u < 256; u += G) { MIX_TID ArgsP a = args_ptr();
#ifdef PROBE_HY
#pragma unroll 1
        for (int rep = 1; rep >= 0; --rep)
#else
        const int rep = 0;
#endif
        hyena_unit2(a, l, u, lds, tid, wave, lane, rep); }
#endif
#ifndef NO_LRU
    for (int u = bx - 128; u >= 0 && u < 4; u += G) { MIX_TID ArgsP a = args_ptr(); lru_carry_unit(a, u, tid); }
#endif
#ifndef NO_ATT
    for (int v = bx; v < 512; v += G) {
        ArgsP a = args_ptr(); const abf* PB = (const abf*)(a->ws + WS_PB); abf* Y = (abf*)(a->ws + WS_XN);
        const int xcd = v & 7, ii = (v & 255) >> 3, rr = v >> 8, uu = 2 * ii + rr;
        const int b = xcd >> 2, kvh = (xcd >> 1) & 1, h = 2 * kvh + (uu & 1), qb = (uu >> 1) * 2 + (xcd & 1);
        AttnJob J; J.Q = PB + 768 + 64 * h; J.K = PB + 1024 + 64 * (h >> 1); J.V = PB + 1152 + 64 * (h >> 1); J.O = Y + 768 + 64 * h;
        J.qrow0 = b * SEQ + qb * 256; J.ctxrow0 = MLAT + b * CTXL; J.bandrow0 = b * SEQ; J.NT = 4 + SEQ / 64; J.qpos0 = qb * 256; J.kpos0 = 0; J.sink2 = 0.f; J.has_sink = 0;
        attn_body::attn_unit<8, false>(J, lds_generic);
#ifdef PROBE_ATT
        attn_body::attn_unit<8, false>(J, lds_generic);
#endif
    }
    for (int v = bx; v < 512; v += G) {
        ArgsP a = args_ptr(); const abf* PB = (const abf*)(a->ws + WS_PB); abf* Y = (abf*)(a->ws + WS_XN);
        const int qb = v & 63, h = (v >> 6) & 3, b = v >> 8;
        const int k0 = (qb == 0) ? 0 : qb * 256 - 128, k1 = (qb == 63) ? SEQ : qb * 256 + 384;
        AttnJob J; J.Q = PB + 256 + 64 * h; J.K = PB + 512 + 64 * (h >> 1); J.V = PB + 640 + 64 * (h >> 1); J.O = Y + 512 + 64 * h;
        J.qrow0 = b * SEQ + qb * 256; J.ctxrow0 = MLAT + b * CTXL; J.bandrow0 = b * SEQ + k0; J.NT = 4 + (k1 - k0) / 64; J.qpos0 = qb * 256; J.kpos0 = k0;
        J.sink2 = a->in[I_SINK][l * 4 + h] * LOG2E; J.has_sink = 1;
        attn_body::attn_unit<8, true>(J, lds_generic);
    }
    if (l + 1 < DEPTH)
    for (int v = bx - 64; v >= 0 && v < 16; v += G) {
        ArgsP a = args_ptr(); const abf* PB = (const abf*)(a->ws + WS_PB); abf* Y = (abf*)(a->ws + WS_XN);
        const int h = v & 3, b = (v >> 2) & 1, glb = v >> 3;
        AttnJob J; J.Q = PB + (glb ? 768 : 256) + 64 * h; J.K = PB + (glb ? 1024 : 512) + 64 * (h >> 1); J.V = PB + (glb ? 1152 : 640) + 64 * (h >> 1); J.O = Y + (glb ? 768 : 512) + 64 * h;
        J.qrow0 = MLAT + b * CTXL; J.ctxrow0 = MLAT + b * CTXL; J.bandrow0 = 0; J.NT = 4; J.qpos0 = 0; J.kpos0 = 0;
        J.sink2 = glb ? 0.f : a->in[I_SINK][l * 4 + h] * LOG2E; J.has_sink = glb ? 0 : 1;
        attn_body::attn_unit<8, false>(J, lds_generic);
    }
#endif
#ifndef NO_CHY
    if (l + 1 < DEPTH)
    for (int u = bx; u < 256; u += G) { MIX_TID ArgsP a = args_ptr(); hyena_ctx_unit(a, l, u, lds, tid, wave, lane); }
#endif
}

#ifdef NO_GEMM
#define GEMM_CALL if (0)
#else
#define GEMM_CALL
#endif
#define LAUNDER_TID int tid = threadIdx.x; asm volatile("" : "+v"(tid)); const int lane = tid & 63, wave = __builtin_amdgcn_readfirstlane(tid >> 6); (void)lane; (void)wave;
template <int l> __device__ __forceinline__ void layer_body(const XcdBarrier& bar, LAS unsigned char* lds, char* lds_generic) {

        {   ArgsP a = args_ptr(); unsigned char* ws = a->ws; bf16_t* XN = (bf16_t*)(ws + WS_XN); bf16_t* Hb = (bf16_t*)(ws + WS_H); float* XC = (float*)(ws + WS_XC); const float* MOD = (const float*)(ws + WS_MOD) + (size_t)l * 3 * NMODV; (void)XN; (void)Hb; (void)XC; (void)MOD;
            pg8::Gemm g{XN, (const bf16_t*)(ws + WS_W13A), MTOT, 2 * DFF, DM, DM, (2 * DFF) / 256}; pg8::StaticOrder S; S.init(MTOT, 2 * DFF, gridDim.x, blockIdx.x);
            EpiSwiGLU E{Hb}; GEMM_CALL pg8::gemm_phase<EpiSwiGLU, pg8::StaticOrder, true, true>(lds, g, S, E);
        }
        xcd_barrier(bar);
        {   ArgsP a = args_ptr(); unsigned char* ws = a->ws; bf16_t* XN = (bf16_t*)(ws + WS_XN); bf16_t* Hb = (bf16_t*)(ws + WS_H); float* XC = (float*)(ws + WS_XC); const float* MOD = (const float*)(ws + WS_MOD) + (size_t)l * 3 * NMODV; (void)XN; (void)Hb; (void)XC; (void)MOD;
            pg8::Gemm g{Hb, (const bf16_t*)(ws + WS_W2A), MLAT, DM, DFF, DFF, (DM) / 256}; pg8::StaticOrder S; S.init(MLAT, DM, gridDim.x, blockIdx.x);
            EpiResid E{a->out, XC, MOD + 2 * DM, 0.5f, (l == 0) ? a->in[I_X] : (const float*)a->out}; GEMM_CALL pg8::gemm_phase<EpiResid, pg8::StaticOrder, true, true>(lds, g, S, E);
            { pg8::Gemm gc{Hb + (size_t)MLAT * DFF, (const bf16_t*)(ws + WS_W2A), NBATCH * CTXL, DM, DFF, DFF / 11, DM / 256}; pg8::StaticOrder Sc; Sc.init(NBATCH * CTXL, DM * 11, gridDim.x, blockIdx.x);
              EpiResidCtxSplitK Ec{(float*)(ws + WS_PART), MOD + 2 * DM, 0.5f, DM / 256}; GEMM_CALL pg8::gemm_phase<EpiResidCtxSplitK, pg8::StaticOrder, true, true>(lds, gc, Sc, Ec); }
        }
        xcd_barrier(bar);
        { LAUNDER_TID ArgsP a = args_ptr(); norm_phase(a, l, 1, wave, lane, 11); }
        xcd_barrier(bar);
        {   ArgsP a = args_ptr(); unsigned char* ws = a->ws; bf16_t* XN = (bf16_t*)(ws + WS_XN); bf16_t* Hb = (bf16_t*)(ws + WS_H); float* XC = (float*)(ws + WS_XC); const float* MOD = (const float*)(ws + WS_MOD) + (size_t)l * 3 * NMODV; (void)XN; (void)Hb; (void)XC; (void)MOD;
            pg8::Gemm g{XN, (const bf16_t*)(ws + WS_WIN), MTOT, DIN, DM, DM, (DIN) / 256}; pg8::StaticOrder S; S.init(MTOT, DIN, gridDim.x, blockIdx.x);
            EpiProj E{(bf16_t*)(ws + WS_PA), (bf16_t*)(ws + WS_PB)}; GEMM_CALL pg8::gemm_phase<EpiProj, pg8::StaticOrder, true, true>(lds, g, S, E);
        }
        xcd_barrier(bar);
#ifndef NO_E1
        { LAUNDER_TID ArgsP a = args_ptr(); e1_phase(a, l, lds, tid, wave, lane); }
#endif
        xcd_barrier(bar);
        {   ArgsP a = args_ptr(); unsigned char* ws = a->ws; bf16_t* XN = (bf16_t*)(ws + WS_XN); bf16_t* Hb = (bf16_t*)(ws + WS_H); float* XC = (float*)(ws + WS_XC); const float* MOD = (const float*)(ws + WS_MOD) + (size_t)l * 3 * NMODV; (void)XN; (void)Hb; (void)XC; (void)MOD;
            pg8::Gemm g{(const bf16_t*)(ws + WS_R), (const bf16_t*)(ws + WS_WLRU), MTOT, 1024, 256, 256, (1024) / 256}; pg8::StaticOrder S; S.init(MTOT, 1024, gridDim.x, blockIdx.x);
            EpiLru E{(unsigned*)(ws + WS_RAW0), (unsigned*)(ws + WS_RAW1)};
            GEMM_CALL pg8::gemm_phase<EpiLru, pg8::StaticOrder, true, true>(lds, g, S, E);
        }
        xcd_barrier(bar);
        { LAUNDER_TID ArgsP a = args_ptr(); lru_gate_phase(a, l, tid); }
        xcd_barrier(bar);
        mix_phase(l, lds, lds_generic);
        xcd_barrier(bar);
        { LAUNDER_TID ArgsP a = args_ptr(); e2_phase(a, lds, tid, wave, lane); }
        xcd_barrier(bar);
        {   ArgsP a = args_ptr(); unsigned char* ws = a->ws; bf16_t* XN = (bf16_t*)(ws + WS_XN); bf16_t* Hb = (bf16_t*)(ws + WS_H); float* XC = (float*)(ws + WS_XC); const float* MOD = (const float*)(ws + WS_MOD) + (size_t)l * 3 * NMODV; (void)XN; (void)Hb; (void)XC; (void)MOD;
            pg8::Gemm g{XN, (const bf16_t*)(ws + WS_WOUT), MLAT, DM, DM, DM, (DM) / 256}; pg8::StaticOrder S; S.init(MLAT, DM, gridDim.x, blockIdx.x);
            EpiResid E{a->out, XC, MOD + 5 * DM, 1.0f, a->out}; GEMM_CALL pg8::gemm_phase<EpiResid, pg8::StaticOrder, true, true>(lds, g, S, E);
            if (l + 1 < DEPTH) { pg8::Gemm gc{XN + (size_t)MLAT * DM, (const bf16_t*)(ws + WS_WOUT), NBATCH * CTXL, DM, DM, DM / 4, DM / 256}; pg8::StaticOrder Sc; Sc.init(NBATCH * CTXL, DM * 4, gridDim.x, blockIdx.x);
              EpiResidCtxSplitK Ec{(float*)(ws + WS_PART), MOD + 5 * DM, 1.0f, DM / 256}; GEMM_CALL pg8::gemm_phase<EpiResidCtxSplitK, pg8::StaticOrder, true, true>(lds, gc, Sc, Ec); }
        }
        xcd_barrier(bar);
        { LAUNDER_TID ArgsP a = args_ptr(); norm_phase(a, l, 2, wave, lane, (l + 1 < DEPTH) ? 4 : 0); }
        xcd_barrier(bar);
        {   ArgsP a = args_ptr(); unsigned char* ws = a->ws; bf16_t* XN = (bf16_t*)(ws + WS_XN); bf16_t* Hb = (bf16_t*)(ws + WS_H); float* XC = (float*)(ws + WS_XC); const float* MOD = (const float*)(ws + WS_MOD) + (size_t)l * 3 * NMODV; (void)XN; (void)Hb; (void)XC; (void)MOD;
            constexpr int M5 = (l + 1 < DEPTH) ? MTOT : MLAT;
            pg8::Gemm g{XN, (const bf16_t*)(ws + WS_W13B), M5, 2 * DFF, DM, DM, (2 * DFF) / 256}; pg8::StaticOrder S; S.init(M5, 2 * DFF, gridDim.x, blockIdx.x);
            EpiSwiGLU E{Hb}; GEMM_CALL pg8::gemm_phase<EpiSwiGLU, pg8::StaticOrder, true, true>(lds, g, S, E);
        }
        xcd_barrier(bar);
        {   ArgsP a = args_ptr(); unsigned char* ws = a->ws; bf16_t* XN = (bf16_t*)(ws + WS_XN); bf16_t* Hb = (bf16_t*)(ws + WS_H); float* XC = (float*)(ws + WS_XC); const float* MOD = (const float*)(ws + WS_MOD) + (size_t)l * 3 * NMODV; (void)XN; (void)Hb; (void)XC; (void)MOD;
            pg8::Gemm g{Hb, (const bf16_t*)(ws + WS_W2B), MLAT, DM, DFF, DFF, (DM) / 256}; pg8::StaticOrder S; S.init(MLAT, DM, gridDim.x, blockIdx.x);
            EpiResid E{a->out, XC, MOD + 8 * DM, 0.5f, a->out}; GEMM_CALL pg8::gemm_phase<EpiResid, pg8::StaticOrder, true, true>(lds, g, S, E);
            if (l + 1 < DEPTH) { pg8::Gemm gc{Hb + (size_t)MLAT * DFF, (const bf16_t*)(ws + WS_W2B), NBATCH * CTXL, DM, DFF, DFF / 11, DM / 256}; pg8::StaticOrder Sc; Sc.init(NBATCH * CTXL, DM * 11, gridDim.x, blockIdx.x);
              EpiResidCtxSplitK Ec{(float*)(ws + WS_PART), MOD + 8 * DM, 0.5f, DM / 256}; GEMM_CALL pg8::gemm_phase<EpiResidCtxSplitK, pg8::StaticOrder, true, true>(lds, gc, Sc, Ec); }
        }
        xcd_barrier(bar);
        if (l + 1 < DEPTH) { LAUNDER_TID ArgsP a = args_ptr(); prep_layer(a, l + 1, lds, tid, wave, lane); norm_phase(a, l + 1, 0, wave, lane, 11); xcd_barrier(bar); }
    }

__global__ void __launch_bounds__(NTHREADS, 2) fwd_megakernel(Args a_byvalue) {
    extern __shared__ __attribute__((aligned(16))) unsigned char lds_raw[];
    cg::grid_group grid = cg::this_grid();
    LAS unsigned char* lds = (LAS unsigned char*)lds_raw;
    volatile LAS unsigned* bst = (volatile LAS unsigned*)(lds + LDS_BYTES - 64);
    if (threadIdx.x < 16) bst[threadIdx.x] = 0u;
    __syncthreads();
    XcdBarrier bar = xcd_barrier_post((unsigned*)args_ptr()->ws, bst);

    { LAUNDER_TID ArgsP a = args_ptr();
#ifndef NO_PRO
    prologue_phase(a, lds, tid, wave, lane);
    prep_layer(a, 0, lds, tid, wave, lane);
#endif
    grid.sync();
    norm_phase(a, 0, 0, wave, lane, 0, true); }
    xcd_barrier(bar);
    layer_body<0>(bar, lds, (char*)lds_raw);
    layer_body<1>(bar, lds, (char*)lds_raw);
    layer_body<2>(bar, lds, (char*)lds_raw);
    layer_body<3>(bar, lds, (char*)lds_raw);
    { LAUNDER_TID ArgsP a = args_ptr(); final_norm_phase(a, wave, lane); }
}

extern "C" void kernel_launch(void* const* d_in, const int* in_sizes, int n_in, void* d_out, int out_size, void* d_ws, size_t ws_size, hipStream_t stream) {
    static int grid_blocks = 0;
    if (grid_blocks == 0) {
        if (n_in != 32 || out_size != MLAT * DM || ws_size < WS_END) { fprintf(stderr, "kernel_launch: unexpected problem: n_in %d out %d ws %zu (need %zu)\n", n_in, out_size, ws_size, (size_t)WS_END); grid_blocks = -1; return; }
        int dev = 0, cus = 0, per_cu = 0;
        hipGetDevice(&dev); hipDeviceGetAttribute(&cus, hipDeviceAttributeMultiprocessorCount, dev);
        hipFuncSetAttribute((const void*)fwd_megakernel, hipFuncAttributeMaxDynamicSharedMemorySize, LDS_BYTES);
        hipOccupancyMaxActiveBlocksPerMultiprocessor(&per_cu, (const void*)fwd_megakernel, NTHREADS, LDS_BYTES);
        if (per_cu < 1) { fprintf(stderr, "kernel_launch: occupancy query says %d blocks per CU\n", per_cu); per_cu = 1; }
        (void)hipGetLastError();
        grid_blocks = cus * per_cu;
    }
    if (grid_blocks < 0) return;
    Args a{};
    for (int i = 0; i < 32; ++i) a.in[i] = (const float*)d_in[i];
    a.out = (float*)d_out; a.ws = (unsigned char*)d_ws;
    (void)hipMemsetAsync(d_ws, 0, 16384, stream);
    void* args[] = {&a};
    hipError_t e = hipLaunchCooperativeKernel((const void*)fwd_megakernel, dim3(grid_blocks), dim3(NTHREADS), args, LDS_BYTES, stream);
    if (e != hipSuccess) fprintf(stderr, "cooperative launch failed: %s (grid %d)\n", hipGetErrorString(e), grid_blocks);
}
```
